# Optimizing an MI355X kernel written in HIP

```python
import math
import jax, jax.numpy as jnp
from jax import lax
import numpy as np

D_MODEL = 2048
BATCH = 1
SEQ = 8192
DEPTH = 2

N_META = 16
F_WIDTH = D_MODEL // 2
F_GROUPS = 4
F_GROUP = F_WIDTH // F_GROUPS
N_HEADS = 16
QK_NOPE = 128
QK_ROPE = 64
QK_HEAD = QK_NOPE + QK_ROPE
V_HEAD = 128
Q_LORA = 768
KV_LORA = 512
ROPE_THETA = 10000.0
C_WIDTH = D_MODEL // 2
N_BRANCH = 3
D_FF = 5632
Q_BLOCK = 128
EPS = 1e-6

OFF_Q = F_WIDTH
OFF_KV = OFF_Q + Q_LORA
OFF_KR = OFF_KV + KV_LORA
OFF_C = OFF_KR + QK_ROPE
OFF_G = OFF_C + 3 * C_WIDTH
N_IN = OFF_G + N_BRANCH * D_MODEL

kernel_name = "hybrid_fnet_mla_shortconv_convffn_encoder"


def _rms(x, g):
    xf = x.astype(jnp.float32)
    y = xf * lax.rsqrt(jnp.mean(xf * xf, axis=-1, keepdims=True) + EPS)
    return (y * g.astype(jnp.float32)).astype(x.dtype)


def _dwconv3(h, w):
    hp = jnp.pad(h, ((0, 0), (1, 1), (0, 0)))
    return hp[:, :-2] * w[0] + hp[:, 1:-1] * w[1] + hp[:, 2:] * w[2]


def _rope_tables(L):
    inv = 1.0 / (ROPE_THETA ** (jnp.arange(0, QK_ROPE, 2, dtype=jnp.float32) / QK_ROPE))
    ang = jnp.arange(L, dtype=jnp.float32)[:, None] * inv[None, :]
    return jnp.cos(ang)[None, :, None, :], jnp.sin(ang)[None, :, None, :]


def _apply_rope(x, cos, sin):
    xf = x.astype(jnp.float32)
    half = QK_ROPE // 2
    x1, x2 = xf[..., :half], xf[..., half:]
    out = jnp.concatenate([x1 * cos - x2 * sin, x2 * cos + x1 * sin], axis=-1)
    return out.astype(x.dtype)


def _attend(q, k, v):
    s = jnp.einsum('bqhd,bkhd->bhqk', q, k).astype(jnp.float32) * (1.0 / math.sqrt(QK_HEAD))
    p = jax.nn.softmax(s, axis=-1)
    return jnp.einsum('bhqk,bkhd->bqhd', p.astype(v.dtype), v)


def _dense_attention(q, k, v):
    B = q.shape[0]
    out_meta = _attend(q[:, :N_META], k, v)
    q_real = q[:, N_META:]
    nb = q_real.shape[1] // Q_BLOCK
    qb = q_real.reshape(B, nb, Q_BLOCK, N_HEADS, QK_HEAD).transpose(1, 0, 2, 3, 4)
    ob = lax.map(lambda qq: _attend(qq, k, v), qb)
    out_real = ob.transpose(1, 0, 2, 3, 4).reshape(B, nb * Q_BLOCK, N_HEADS, V_HEAD)
    return jnp.concatenate([out_meta, out_real], axis=1)


def _mixer(xn, cos, sin, w_in, g_qa, g_kva, w_uq, w_ukv, g_q, g_k, conv_c,
           w_pa, w_pb, w_pc, w_o):
    B, L, _ = xn.shape
    p = xn @ w_in
    a = p[..., :OFF_Q]
    cq = p[..., OFF_Q:OFF_KV]
    ckv = p[..., OFF_KV:OFF_KR]
    k_rope = p[..., OFF_KR:OFF_C]
    cb, cc, ch = jnp.split(p[..., OFF_C:OFF_G], 3, axis=-1)
    gates = p[..., OFF_G:]

    fa = jnp.fft.fft2(a.reshape(B, L, F_GROUPS, F_GROUP).astype(jnp.float32),
                      axes=(1, 3), norm='ortho').real
    ya = fa.reshape(B, L, F_WIDTH).astype(xn.dtype) @ w_pa

    q = (_rms(cq, g_qa) @ w_uq).reshape(B, L, N_HEADS, QK_HEAD)
    kv = (_rms(ckv, g_kva) @ w_ukv).reshape(B, L, N_HEADS, QK_NOPE + V_HEAD)
    k_nope, v = kv[..., :QK_NOPE], kv[..., QK_NOPE:]
    k_r = jnp.broadcast_to(k_rope[:, :, None, :], (B, L, N_HEADS, QK_ROPE))
    k = jnp.concatenate([k_nope, k_r], axis=-1)
    q = _rms(q, g_q)
    k = _rms(k, g_k)
    q = jnp.concatenate([q[..., :QK_NOPE], _apply_rope(q[..., QK_NOPE:], cos, sin)], axis=-1)
    k = jnp.concatenate([k[..., :QK_NOPE], _apply_rope(k[..., QK_NOPE:], cos, sin)], axis=-1)
    o = _dense_attention(q, k, v)
    yb = o.reshape(B, L, N_HEADS * V_HEAD) @ w_pb

    yc = (cb * _dwconv3(cc * ch, conv_c)) @ w_pc

    g = jax.nn.sigmoid(gates.astype(jnp.float32)).astype(xn.dtype).reshape(B, L, N_BRANCH, D_MODEL)
    merged = g[..., 0, :] * ya + g[..., 1, :] * yb + g[..., 2, :] * yc
    return merged @ w_o


def _conv_ffn(xn, w_up, conv_ffn, w_down):
    h = _dwconv3(xn @ w_up, conv_ffn)
    a, b = h[..., :D_FF], h[..., D_FF:]
    return (jax.nn.silu(a) * b) @ w_down


def setup_inputs(seed: int = 0) -> dict:
    key = jax.random.key(seed)
    ks = jax.random.split(key, 20)
    f32 = jnp.float32

    def nrm(k, shape, scale):
        return jax.random.normal(k, shape, f32) * scale

    def gain(k, shape):
        return 1.0 + 0.01 * jax.random.normal(k, shape, f32)

    return {
        "x": nrm(ks[0], (BATCH, SEQ, D_MODEL), 1.0),
        "meta_tokens": nrm(ks[1], (N_META, D_MODEL), 1.0),
        "g_mix": gain(ks[2], (DEPTH, D_MODEL)),
        "w_in": nrm(ks[3], (DEPTH, D_MODEL, N_IN), D_MODEL ** -0.5),
        "g_qa": gain(ks[4], (DEPTH, Q_LORA)),
        "g_kva": gain(ks[5], (DEPTH, KV_LORA)),
        "w_uq": nrm(ks[6], (DEPTH, Q_LORA, N_HEADS * QK_HEAD), Q_LORA ** -0.5),
        "w_ukv": nrm(ks[7], (DEPTH, KV_LORA, N_HEADS * (QK_NOPE + V_HEAD)), KV_LORA ** -0.5),
        "g_q": gain(ks[8], (DEPTH, QK_HEAD)),
        "g_k": gain(ks[9], (DEPTH, QK_HEAD)),
        "conv_c": nrm(ks[10], (DEPTH, 3, C_WIDTH), 3 ** -0.5),
        "w_pa": nrm(ks[11], (DEPTH, F_WIDTH, D_MODEL), F_WIDTH ** -0.5),
        "w_pb": nrm(ks[12], (DEPTH, N_HEADS * V_HEAD, D_MODEL), (N_HEADS * V_HEAD) ** -0.5),
        "w_pc": nrm(ks[13], (DEPTH, C_WIDTH, D_MODEL), C_WIDTH ** -0.5),
        "w_o": nrm(ks[14], (DEPTH, D_MODEL, D_MODEL), D_MODEL ** -0.5),
        "g_ffn": gain(ks[15], (DEPTH, D_MODEL)),
        "w_up": nrm(ks[16], (DEPTH, D_MODEL, 2 * D_FF), D_MODEL ** -0.5),
        "conv_ffn": nrm(ks[17], (DEPTH, 3, 2 * D_FF), 3 ** -0.5),
        "w_down": nrm(ks[18], (DEPTH, D_FF, D_MODEL), D_FF ** -0.5),
    }


def reference(x, meta_tokens, g_mix, w_in, g_qa, g_kva, w_uq, w_ukv, g_q, g_k, conv_c,
              w_pa, w_pb, w_pc, w_o, g_ffn, w_up, conv_ffn, w_down):
    B = x.shape[0]
    meta = jnp.broadcast_to(meta_tokens[None].astype(x.dtype), (B, N_META, D_MODEL))
    h = jnp.concatenate([meta, x], axis=1)
    cos, sin = _rope_tables(h.shape[1])
    for l in range(DEPTH):
        h = h + _mixer(_rms(h, g_mix[l]), cos, sin, w_in[l], g_qa[l], g_kva[l],
                       w_uq[l], w_ukv[l], g_q[l], g_k[l], conv_c[l],
                       w_pa[l], w_pb[l], w_pc[l], w_o[l])
        h = h + _conv_ffn(_rms(h, g_ffn[l]), w_up[l], conv_ffn[l], w_down[l])
    return h[:, N_META:]
```

```cpp
#include <hip/hip_runtime.h>
#include <hip/hip_cooperative_groups.h>
#include <cstdio>
#include <cstdint>
namespace cg = cooperative_groups;

#define LAS __attribute__((address_space(3)))
typedef unsigned short bf16_t;
typedef short bf16x8 __attribute__((ext_vector_type(8)));
typedef short s16x4 __attribute__((ext_vector_type(4)));
typedef float f32x4 __attribute__((ext_vector_type(4)));
typedef float f32x16 __attribute__((ext_vector_type(16)));
typedef unsigned u32x4 __attribute__((ext_vector_type(4)));
typedef unsigned u32x2 __attribute__((ext_vector_type(2)));

constexpr int LSEQ = 8208, LREAL = 8192, MP = 8448, DM = 2048;
constexpr int HF = 4104, MH = 4352;
constexpr int NIN = 11584, NPIN = 11776, NPA = 5376, NKR = 256, NPG = 6144;
constexpr int QL = 768, KVL = 512, NQ = 3072, NKV = 4096;
constexpr int DFF = 5632, NUP = 11264;
constexpr float EPS = 1e-6f;
constexpr int NMP = 7;

constexpr size_t al256(size_t x) { return (x + 255) & ~(size_t)255; }
constexpr size_t SZ_W0 = (size_t)NPIN * DM * 2;
constexpr size_t OW_UQ = 0, OW_UKV = OW_UQ + (size_t)NQ * QL * 2, OW_PA = OW_UKV + (size_t)NKV * KVL * 2, OW_PB = OW_PA + (size_t)DM * 1024 * 2,
                 OW_PC = OW_PB + (size_t)DM * DM * 2, OW_O = OW_PC + (size_t)DM * 1024 * 2, SZ_W1 = OW_O + (size_t)DM * DM * 2;
constexpr size_t O_W0 = 0;
constexpr size_t O_W1 = O_W0 + al256(SZ_W0);
constexpr size_t O_CH = O_W1 + al256(SZ_W1);
constexpr size_t O_SH = O_CH + al256((size_t)MH * MH * 2);
constexpr size_t O_CS = O_SH + al256((size_t)MH * MH * 2);
constexpr size_t O_ROPE = O_CS + al256((size_t)2 * 256 * 256 * 2);
constexpr size_t O_H = O_ROPE + al256((size_t)LSEQ * 64 * 4);
constexpr size_t O_X = O_H + al256((size_t)MP * DM * 4);
constexpr size_t O_PA = O_X + al256((size_t)MP * DM * 2);
constexpr size_t O_PG = O_PA + al256((size_t)MP * NPA * 2);
constexpr size_t O_KR = O_PG + al256((size_t)MP * NPG * 2);
constexpr size_t O_KV = O_KR + al256((size_t)MP * NKR * 2);
constexpr size_t O_KP = O_KV + al256((size_t)MP * NKV * 2);
constexpr size_t O_CC = O_KP + al256((size_t)MP * NQ * 2);
constexpr size_t O_EO = O_CC + al256((size_t)MP * 1024 * 2);
constexpr size_t O_MG = O_EO + al256((size_t)2 * MH * 1024 * 2);
constexpr size_t O_MB = O_MG + al256((size_t)MP * DM * 4);
constexpr size_t O_WD = O_MB + al256((size_t)MP * DM * 2);
constexpr size_t O_PM = O_WD + al256((size_t)DM * DFF * 2);
constexpr size_t PM_L = (size_t)16 * 16 * 16 * 128;
constexpr size_t O_CTL = O_PM + al256((PM_L + 16 * 16 * 16) * 4), CTL_BYTES = 16384;
constexpr size_t WS_END = O_CTL + CTL_BYTES;
constexpr size_t O_Q = O_PA, O_ET = O_Q + (size_t)MP * NQ * 2, O_UW = O_ET + (size_t)2 * 1024 * MH * 2;
static_assert(O_UW + (size_t)2 * MH * 1024 * 2 <= O_PG, "PA hosting");
static_assert((size_t)MP * NUP * 2 <= O_KR - O_PA, "u over pA|pG");
static_assert((size_t)MP * DFF * 2 <= O_CC - O_KV, "gated over kv|kp");
static_assert((size_t)DM * DFF * 2 <= SZ_W1 && (size_t)NUP * DM * 2 <= SZ_W0, "weight slots");

__device__ __forceinline__ unsigned cvt_pk_bf16(float lo, float hi) { unsigned r; asm volatile("v_cvt_pk_bf16_f32 %0, %1, %2" : "=v"(r) : "v"(lo), "v"(hi)); return r; }
__device__ __forceinline__ float bf_lo(unsigned w) { return __uint_as_float(w << 16); }
__device__ __forceinline__ float bf_hi(unsigned w) { return __uint_as_float(w & 0xffff0000u); }
__device__ __forceinline__ float bf1(bf16_t v) { return __uint_as_float(((unsigned)v) << 16); }
__device__ __forceinline__ bf16_t to_bf1(float f) { return (bf16_t)(cvt_pk_bf16(f, 0.f) & 0xffffu); }
__device__ __forceinline__ float shx(float v, int o, int lane) { return __int_as_float(__builtin_amdgcn_ds_bpermute((lane ^ o) << 2, __float_as_int(v))); }
__device__ __forceinline__ float wave_sum(float v, int lane) {
#pragma unroll
    for (int o = 1; o < 64; o <<= 1) v += shx(v, o, lane);
    return v;
}
__device__ __forceinline__ float sigm(float x) { return __builtin_amdgcn_rcpf(1.f + __builtin_amdgcn_exp2f(-1.4426950408889634f * x)); }
__device__ __forceinline__ int row_left(int r) { return r >= LSEQ ? -1 : (r == 0 ? LSEQ - 1 : (r == LREAL ? -1 : r - 1)); }
__device__ __forceinline__ int row_right(int r) { return r >= LSEQ ? -1 : (r == LREAL - 1 ? -1 : (r == LSEQ - 1 ? 0 : r + 1)); }
__device__ __forceinline__ int phys_of(int l) { return l >= 16 ? l - 16 : LREAL + l; }
__device__ __forceinline__ int pos_of(int r) { return r < LREAL ? r + 16 : r - LREAL; }
#define LDS_WAIT() asm volatile("s_waitcnt lgkmcnt(0)" ::: "memory")

namespace pg8 {
constexpr int BM = 256, BK = 64, HALF = 128, HTB = HALF * BK * 2, STAGE_BYTES = 8 * HTB, NXCD = 8, WGM = 8;
__device__ __forceinline__ int lds_byte(int r, int c) { const int st = (r >> 4) * 2 + (c >> 5), rr = r & 15, cc = c & 31, ob = rr * 64 + cc * 2; return st * 1024 + (ob ^ (((ob >> 9) & 1) << 5)); }
__device__ __forceinline__ void stage_rc(int b, int& R, int& C) { const int st = b / 1024, sb = b % 1024, swz = sb ^ (((sb >> 9) & 1) << 5); R = (st >> 1) * 16 + swz / 64; C = (st & 1) * 32 + (swz % 64) / 2; }
__device__ __forceinline__ int perm32(int rho) { const int n = rho >> 4, i = rho & 15; return 8 * (i >> 2) + 4 * n + (i & 3); }

struct Unit { int pm, pn, pb; };
enum { EPI_PIN = 0, EPI_BF16 = 1, EPI_MERGE0 = 2, EPI_MERGE1 = 3, EPI_MERGE2 = 4, EPI_RESID = 5, EPI_OUT = 6 };
struct Desc {
    const bf16_t* A; const bf16_t* Bt; int M, N, K, lda, ldb;
    int nb, nb2s; long sA1, sA2, sB1, sB2;
    int epi; void* o0; void* o1; void* o2; const bf16_t* gate; int ldc; long sO; float scale;
};
struct Order {
    int nM, nN, per, nwg, G, c;
    __device__ __forceinline__ void init(int M, int N, int nb, int G_, int c_) { nM = M / BM; nN = N / BM; per = nM * nN; nwg = per * nb; G = G_; c = c_; }
    __device__ __forceinline__ bool next(int i, Unit& u) const {
        const long L = (long)i * G + c; if (L >= nwg) return false;
        u.pb = (int)(L / per); int wgid = (int)(L % per);
        { const int q = per / NXCD, r = per % NXCD, xcd = wgid % NXCD, off = wgid / NXCD; wgid = (xcd < r ? xcd * (q + 1) : r * (q + 1) + (xcd - r) * q) + off; }
        const int nig = WGM * nN, gid = wgid / nig, fm = gid * WGM, gsz = (nM - fm) < WGM ? (nM - fm) : WGM;
        u.pm = fm + ((wgid % nig) % gsz); u.pn = (wgid % nig) / gsz; return true;
    }
};
__device__ __forceinline__ const char* unitA(const Desc& d, const Unit& u) {
    return (const char*)d.A + ((size_t)(u.pb >> d.nb2s) * d.sA1 + (size_t)(u.pb & ((1 << d.nb2s) - 1)) * d.sA2 + (size_t)u.pm * 256 * d.lda) * 2; }
__device__ __forceinline__ const char* unitB(const Desc& d, const Unit& u) {
    return (const char*)d.Bt + ((size_t)(u.pb >> d.nb2s) * d.sB1 + (size_t)(u.pb & ((1 << d.nb2s) - 1)) * d.sB2 + (size_t)u.pn * 256 * d.ldb) * 2; }

__device__ __forceinline__ f32x4 zero4() { float a, b, c, e; asm volatile("v_mov_b32 %0, 0\n\tv_mov_b32 %1, 0\n\tv_mov_b32 %2, 0\n\tv_mov_b32 %3, 0" : "=v"(a), "=v"(b), "=v"(c), "=v"(e)); return (f32x4){a, b, c, e}; }
__device__ __forceinline__ f32x4 sigm4(unsigned lo, unsigned hi) { f32x4 r; r[0] = sigm(bf_lo(lo)); r[1] = sigm(bf_hi(lo)); r[2] = sigm(bf_lo(hi)); r[3] = sigm(bf_hi(hi)); return r; }
__device__ __forceinline__ u32x4 pack8(f32x4 v0, f32x4 v1) { u32x4 w; w.x = cvt_pk_bf16(v0[0], v0[1]); w.y = cvt_pk_bf16(v0[2], v0[3]); w.z = cvt_pk_bf16(v1[0], v1[1]); w.w = cvt_pk_bf16(v1[2], v1[3]); return w; }

__device__ __forceinline__ void epi8(const Desc& d, int pb, int row, int col, f32x4 v0, f32x4 v1) {
    if (d.epi == EPI_PIN) {
        const int pn = col >> 8; bf16_t* p;
        if (pn < 21) p = (bf16_t*)d.o0 + (size_t)row * NPA + col;
        else if (pn == 21) p = (bf16_t*)d.o1 + (size_t)row * NKR + (col - 21 * 256);
        else p = (bf16_t*)d.o2 + (size_t)row * NPG + (col - 22 * 256);
        *(u32x4*)p = pack8(v0, v1);
    } else if (d.epi == EPI_BF16) {
        *(u32x4*)((bf16_t*)d.o0 + (size_t)pb * d.sO + (size_t)row * d.ldc + col) = pack8(v0 * d.scale, v1 * d.scale);
    } else if (d.epi == EPI_MERGE0 || d.epi == EPI_MERGE1 || d.epi == EPI_MERGE2) {
        const u32x4 gw = *(const u32x4*)(d.gate + (size_t)row * NPG + col);
        v0 *= sigm4(gw.x, gw.y); v1 *= sigm4(gw.z, gw.w);
        bf16_t* mp = (bf16_t*)d.o0 + (size_t)row * DM + col;
        if (d.epi != EPI_MERGE0) { const u32x4 m = *(const u32x4*)mp;
            v0 += (f32x4){bf_lo(m.x), bf_hi(m.x), bf_lo(m.y), bf_hi(m.y)}; v1 += (f32x4){bf_lo(m.z), bf_hi(m.z), bf_lo(m.w), bf_hi(m.w)}; }
        if (d.epi != EPI_MERGE2) *(u32x4*)mp = pack8(v0, v1);
        else *(u32x4*)((bf16_t*)d.o1 + (size_t)row * DM + col) = pack8(v0, v1);
    } else {
        bf16_t* hp = (bf16_t*)d.o0 + (size_t)row * DM + col;
        if (d.ldc) { const float* rp = (row < LREAL ? (const float*)d.o2 + (size_t)row * DM : (const float*)d.gate + (size_t)(row - LREAL) * DM) + col;
            v0 += *(const f32x4*)rp; v1 += *(const f32x4*)(rp + 4); }
        else { const u32x4 m = *(const u32x4*)hp;
            v0 += (f32x4){bf_lo(m.x), bf_hi(m.x), bf_lo(m.y), bf_hi(m.y)}; v1 += (f32x4){bf_lo(m.z), bf_hi(m.z), bf_lo(m.w), bf_hi(m.w)}; }
        if (d.epi == EPI_RESID) *(u32x4*)hp = pack8(v0, v1);
        else if (row < LREAL) { float* op = (float*)d.o1 + (size_t)row * DM + col; *(f32x4*)op = v0; *(f32x4*)(op + 4) = v1; }
    }
}
__device__ __forceinline__ void epilogue(const Desc& d, const f32x4 (&acc)[2][2][4][2], const Unit& u, int wr, int wc, int fr, int fq) {
    const int row0 = u.pm * BM + wr * 64 + fr, col0 = u.pn * BM + wc * 32 + 8 * fq;
#pragma unroll
    for (int ai = 0; ai < 2; ++ai)
#pragma unroll
        for (int m = 0; m < 4; ++m) {
#pragma unroll
            for (int bj = 0; bj < 2; ++bj) epi8(d, u.pb, row0 + ai * HALF + m * 16, col0 + bj * HALF, acc[ai][bj][m][0], acc[ai][bj][m][1]);
            asm volatile("" ::: "memory"); }
}

__device__ __forceinline__ void skinny_phase(LAS unsigned char* lds, const Desc& g, int G, int bx, int wave, int lane) {
    asm volatile("" : "+v"(lane));
    const int fr = lane & 15, fq = lane >> 4, ks = g.K >> 3;
    const bf16_t* Ap = g.A + (size_t)(LREAL + fr) * g.lda + wave * ks + fq * 8;
    LAS f32x4* red = (LAS f32x4*)lds;
    if (bx >= 0)
    for (int grp = bx; grp < (g.N >> 5); grp += G) {
        const int c0 = grp * 32;
        const bf16_t* W0p = g.Bt + (size_t)(c0 + perm32(fr)) * g.ldb + wave * ks + fq * 8;
        const bf16_t* W1p = g.Bt + (size_t)(c0 + perm32(16 + fr)) * g.ldb + wave * ks + fq * 8;
        f32x4 a0 = zero4(), a1 = zero4();
#pragma unroll 8
        for (int kk = 0; kk < ks; kk += 32) {
            const bf16x8 af = *(const bf16x8*)(Ap + kk), w0 = *(const bf16x8*)(W0p + kk), w1 = *(const bf16x8*)(W1p + kk);
            a0 = __builtin_amdgcn_mfma_f32_16x16x32_bf16(w0, af, a0, 0, 0, 0);
            a1 = __builtin_amdgcn_mfma_f32_16x16x32_bf16(w1, af, a1, 0, 0, 0);
        }
        red[(wave * 64 + lane) * 2] = a0; red[(wave * 64 + lane) * 2 + 1] = a1;
        __syncthreads();
        if (wave == 0) {
#pragma unroll
            for (int w = 1; w < 8; ++w) { a0 += red[(w * 64 + lane) * 2]; a1 += red[(w * 64 + lane) * 2 + 1]; }
            epi8(g, 0, LREAL + fr, c0 + 8 * fq, a0, a1);
        }
        __syncthreads();
    }
}

__device__ __forceinline__ void gemm_phase(LAS unsigned char* lds, const Desc& g, int G, int cidx, int tid) {
    asm volatile("" : "+v"(tid));
    const int wid = __builtin_amdgcn_readfirstlane(tid >> 6), lane = tid & 63, wr = wid >> 2, wc = wid & 3, fr = lane & 15, fq = lane >> 4;
    Order S; S.init(g.M, g.N, g.nb, G, cidx);
    const int K = g.K, nt = K / BK;
    unsigned voffA[2], voffB[2];
#pragma unroll
    for (int i = 0; i < 2; ++i) { int R, C; stage_rc(tid * 16 + i * 8192, R, C); const int Rb = (R & ~31) + perm32(R & 31);
        voffA[i] = (unsigned)(R * g.lda + C) * 2u; voffB[i] = (unsigned)(Rb * g.ldb + C) * 2u; }
    const size_t kstep = (size_t)(BK * 2);
    const size_t hstepA = (size_t)HALF * g.lda * 2, hstepB = (size_t)HALF * g.ldb * 2;
    const unsigned ldsw = (unsigned)wid * 1024u;
    const int aoff = lds_byte(wr * 64 + fr, fq * 8), boff = lds_byte(wc * 32 + fr, fq * 8);
#define PG8_SA(b, h) (((b) * 2 + (h)) * HTB)
#define PG8_SB(b, h) ((4 + (b) * 2 + (h)) * HTB)
#define PG8_STAGE(bufoff, gbase, voff) do { _Pragma("unroll") for (int _i = 0; _i < 2; ++_i) \
        __builtin_amdgcn_global_load_lds((const unsigned*)((const char*)(gbase) + (voff)[_i]), (LAS unsigned*)(lds + (bufoff) + ldsw + _i * 8192), 16, 0, 0); } while (0)
#define PG8_LDA(dst, b, h) do { _Pragma("unroll") for (int m = 0; m < 4; ++m) _Pragma("unroll") for (int k = 0; k < 2; ++k) dst[m][k] = *(const LAS bf16x8*)(lds + PG8_SA(b, h) + aoff + m * 2048 + k * 1024); } while (0)
#define PG8_LDB(dst, b, h) do { _Pragma("unroll") for (int n = 0; n < 2; ++n) _Pragma("unroll") for (int k = 0; k < 2; ++k) dst[n][k] = *(const LAS bf16x8*)(lds + PG8_SB(b, h) + boff + n * 2048 + k * 1024); } while (0)
#define PG8_MMA(ai, bj, At, Bt) do { __builtin_amdgcn_s_setprio(1); _Pragma("unroll") for (int m = 0; m < 4; ++m) _Pragma("unroll") for (int n = 0; n < 2; ++n) _Pragma("unroll") for (int k = 0; k < 2; ++k) \
        acc[ai][bj][m][n] = __builtin_amdgcn_mfma_f32_16x16x32_bf16(Bt[n][k], At[m][k], acc[ai][bj][m][n], 0, 0, 0); __builtin_amdgcn_s_setprio(0); } while (0)
#define PG8_WAIT_V(n) asm volatile("s_waitcnt vmcnt(" #n ")" ::: "memory")
#define PG8_WAIT_L(n) asm volatile("s_waitcnt lgkmcnt(" #n ")" ::: "memory")
#define PG8_BAR __builtin_amdgcn_s_barrier()
#define PG8_SCHED __builtin_amdgcn_sched_barrier(0)
    Unit cur, nxt; int ui = 0;
    if (!S.next(0, cur)) return;
    f32x4 acc[2][2][4][2];
#pragma unroll
    for (int a = 0; a < 2; ++a)
#pragma unroll
        for (int b = 0; b < 2; ++b)
#pragma unroll
            for (int m = 0; m < 4; ++m)
#pragma unroll
                for (int n = 0; n < 2; ++n) acc[a][b][m][n] = zero4();
    bf16x8 At[4][2], B0[2][2], B1[2][2];
    const char* cA = unitA(g, cur); const char* cB = unitB(g, cur);
    PG8_STAGE(PG8_SB(0, 0), cB, voffB); PG8_STAGE(PG8_SB(0, 1), cB + hstepB, voffB); PG8_STAGE(PG8_SA(0, 0), cA, voffA); PG8_STAGE(PG8_SA(0, 1), cA + hstepA, voffA);
    if (wr == 1) PG8_BAR;
    PG8_WAIT_V(2); PG8_BAR;
    PG8_STAGE(PG8_SB(1, 0), cB + kstep, voffB); PG8_STAGE(PG8_SA(1, 0), cA + kstep, voffA); PG8_STAGE(PG8_SB(1, 1), cB + hstepB + kstep, voffB);
    PG8_WAIT_V(6); PG8_BAR;
    for (;;) {
        const bool has_next = S.next(ui + 1, nxt);
        const char* nA = has_next ? unitA(g, nxt) : cA; const char* nB = has_next ? unitB(g, nxt) : cB;
        for (int t = 0; t < nt; t += 2) {
            const bool last = (t == nt - 2);
            const char* a1 = cA + (size_t)(t + 1) * kstep;
            const char* a2 = last ? nA : cA + (size_t)(t + 2) * kstep; const char* b2 = last ? nB : cB + (size_t)(t + 2) * kstep;
            const char* a3 = a2 + kstep; const char* b3 = b2 + kstep;
            PG8_LDB(B0, 0, 0); PG8_LDB(B1, 0, 1); PG8_SCHED; PG8_LDA(At, 0, 0); PG8_STAGE(PG8_SA(1, 1), a1 + hstepA, voffA);
            PG8_WAIT_V(8); PG8_WAIT_L(0); PG8_BAR; PG8_MMA(0, 0, At, B0); PG8_MMA(0, 1, At, B1); PG8_BAR; PG8_SCHED;
            PG8_LDA(At, 0, 1); PG8_STAGE(PG8_SB(0, 0), b2, voffB); PG8_STAGE(PG8_SB(0, 1), b2 + hstepB, voffB); PG8_STAGE(PG8_SA(0, 0), a2, voffA);
            PG8_WAIT_V(8); PG8_WAIT_L(0); PG8_BAR; PG8_MMA(1, 0, At, B0); PG8_MMA(1, 1, At, B1); PG8_BAR; PG8_SCHED;
            PG8_LDB(B0, 1, 0); PG8_LDB(B1, 1, 1); PG8_SCHED; PG8_LDA(At, 1, 0); PG8_STAGE(PG8_SA(0, 1), a2 + hstepA, voffA);
            PG8_WAIT_V(8); PG8_WAIT_L(0); PG8_BAR; PG8_MMA(0, 0, At, B0); PG8_MMA(0, 1, At, B1); PG8_BAR; PG8_SCHED;
            PG8_LDA(At, 1, 1); PG8_STAGE(PG8_SB(1, 0), b3, voffB); PG8_STAGE(PG8_SB(1, 1), b3 + hstepB, voffB); PG8_STAGE(PG8_SA(1, 0), a3, voffA);
            PG8_WAIT_V(8); PG8_WAIT_L(0); PG8_BAR; PG8_MMA(1, 0, At, B0); PG8_MMA(1, 1, At, B1); PG8_BAR; PG8_SCHED;
        }
        if (wr == 0) PG8_BAR;
        epilogue(g, acc, cur, wr, wc, fr, fq);
        if (!has_next) break;
#pragma unroll
        for (int a = 0; a < 2; ++a)
#pragma unroll
            for (int b = 0; b < 2; ++b)
#pragma unroll
                for (int m = 0; m < 4; ++m)
#pragma unroll
                    for (int n = 0; n < 2; ++n) acc[a][b][m][n] = zero4();
        cur = nxt; cA = nA; cB = nB; ++ui;
        if (wr == 1) PG8_BAR;
    }
    PG8_WAIT_V(0);
    PG8_BAR;
#undef PG8_SA
#undef PG8_SB
#undef PG8_STAGE
#undef PG8_LDA
#undef PG8_LDB
#undef PG8_MMA
#undef PG8_WAIT_V
#undef PG8_WAIT_L
#undef PG8_BAR
#undef PG8_SCHED
}
}

namespace att {
constexpr int KVBLK = 64, NW = 8, LDQ = NQ, LDKK = NQ, LDV = NKV, LDO = DM;
constexpr int SHM_V = 64 * 128 * 2, SHM_K = 64 * 192 * 2;
constexpr int QREG = 8;
constexpr int LDS_V = 0, LDS_K = 2 * SHM_V, LDS_WS = LDS_K + 2 * SHM_K, LDS_QT = LDS_WS + NW * 64 * 4, LDS_BYTES = LDS_QT + NW * (12 - QREG) * 1024;
constexpr int NT = (LSEQ + KVBLK - 1) / KVBLK;
static_assert(NT % 2 == 1 && LSEQ - (NT - 1) * KVBLK == 16, "tail mask assumes 16 valid keys in an odd last tile");
#define KSWZ(row, colB) ((row) * 384 + ((colB) ^ ((((row) >> 1) & 7) << 4)))
#define SBAR() __builtin_amdgcn_sched_barrier(0)
__device__ __forceinline__ int crow(int r, int hi) { return (r & 3) + 8 * (r >> 2) + 4 * hi; }
__device__ __forceinline__ int v_st(int k, int c) { const int kk = (k & ~0xC) | ((k & 4) << 1) | ((k & 8) >> 1); return ((kk >> 3) * 4 + (c >> 5)) * 512 + ((kk & 7) * 32 + (c & 31)) * 2; }
__device__ __forceinline__ int v_rd_base(int lane) { return ((lane & 3) << 3) | (((lane >> 2) & 3) << 6) | (((lane >> 4) & 1) << 5) | (((lane >> 5) & 1) << 8); }
constexpr int v_rd_off(int d0, int ks, int half) { return d0 * 512 + ks * 4096 + half * 2048; }
template <int OFF> __device__ __forceinline__ s16x4 tr_read(int vb) {
    s16x4 r; asm volatile("ds_read_b64_tr_b16 %0, %1 offset:%2" : "=&v"(r) : "v"(vb), "i"(OFF) : "memory"); return r;
}
struct VBlk { s16x4 l0, h0, l1, h1, l2, h2, l3, h3; };
template <int D0> __device__ __forceinline__ void pv_load(VBlk& b, int vb) {
    b.l0 = tr_read<v_rd_off(D0, 0, 0)>(vb); b.h0 = tr_read<v_rd_off(D0, 0, 1)>(vb); b.l1 = tr_read<v_rd_off(D0, 1, 0)>(vb); b.h1 = tr_read<v_rd_off(D0, 1, 1)>(vb);
    b.l2 = tr_read<v_rd_off(D0, 2, 0)>(vb); b.h2 = tr_read<v_rd_off(D0, 2, 1)>(vb); b.l3 = tr_read<v_rd_off(D0, 3, 0)>(vb); b.h3 = tr_read<v_rd_off(D0, 3, 1)>(vb);
}
__device__ __forceinline__ void pv_mma(f32x16& od, const VBlk& b, bf16x8 pa0, bf16x8 pa1, bf16x8 pa2, bf16x8 pa3) {
#define PK(L, H) (bf16x8){L[0], L[1], L[2], L[3], H[0], H[1], H[2], H[3]}
    od = __builtin_amdgcn_mfma_f32_32x32x16_bf16(pa0, PK(b.l0, b.h0), od, 0, 0, 0);
    od = __builtin_amdgcn_mfma_f32_32x32x16_bf16(pa1, PK(b.l1, b.h1), od, 0, 0, 0);
    od = __builtin_amdgcn_mfma_f32_32x32x16_bf16(pa2, PK(b.l2, b.h2), od, 0, 0, 0);
    od = __builtin_amdgcn_mfma_f32_32x32x16_bf16(pa3, PK(b.l3, b.h3), od, 0, 0, 0);
#undef PK
}
__device__ __forceinline__ void pv_d0(f32x16* o, int vb, bf16x8 pa0, bf16x8 pa1, bf16x8 pa2, bf16x8 pa3) {
    VBlk A, B;
    pv_load<0>(A, vb); pv_load<1>(B, vb);
    asm volatile("s_waitcnt lgkmcnt(8)" ::: "memory"); SBAR(); pv_mma(o[0], A, pa0, pa1, pa2, pa3); SBAR();
    pv_load<2>(A, vb);
    asm volatile("s_waitcnt lgkmcnt(8)" ::: "memory"); SBAR(); pv_mma(o[1], B, pa0, pa1, pa2, pa3); SBAR();
    pv_load<3>(B, vb);
    asm volatile("s_waitcnt lgkmcnt(8)" ::: "memory"); SBAR(); pv_mma(o[2], A, pa0, pa1, pa2, pa3); SBAR();
    asm volatile("s_waitcnt lgkmcnt(0)" ::: "memory"); SBAR(); pv_mma(o[3], B, pa0, pa1, pa2, pa3); SBAR();
}
__device__ __forceinline__ void qkt(f32x16& p0, f32x16& p1, LAS const unsigned char* Ks, const bf16x8* qr, LAS const unsigned char* qt, int r32, int hi) {
    p0 = (f32x16){}; p1 = (f32x16){};
#pragma unroll
    for (int d0 = 0; d0 < 12; ++d0) { const int cb = (d0 * 16 + hi * 8) * 2;
        const bf16x8 b0 = *(const LAS bf16x8*)(Ks + KSWZ(r32, cb));
        const bf16x8 b1 = *(const LAS bf16x8*)(Ks + KSWZ(32 + r32, cb));
        const bf16x8 qf = d0 < QREG ? qr[d0 < QREG ? d0 : 0] : *(const LAS bf16x8*)(qt + (d0 - QREG) * 1024);
        p0 = __builtin_amdgcn_mfma_f32_32x32x16_bf16(b0, qf, p0, 0, 0, 0);
        p1 = __builtin_amdgcn_mfma_f32_32x32x16_bf16(b1, qf, p1, 0, 0, 0);
        if ((d0 & 3) == 3) SBAR(); }
}
__device__ __forceinline__ void expP(f32x16& p0, f32x16& p1, float MB) {
#pragma unroll
    for (int r = 0; r < 16; ++r) p0[r] = __builtin_amdgcn_exp2f(p0[r] - MB);
#pragma unroll
    for (int r = 0; r < 16; ++r) p1[r] = __builtin_amdgcn_exp2f(p1[r] - MB);
}
__device__ __forceinline__ void maskLast(f32x16& p0, f32x16& p1) {
#pragma unroll
    for (int r = 8; r < 16; ++r) p0[r] = 0.f;
#pragma unroll
    for (int r = 0; r < 16; ++r) p1[r] = 0.f;
}
__device__ __forceinline__ void finishP(const f32x16& p0, const f32x16& p1, float& l_reg, bf16x8& pa0, bf16x8& pa1, bf16x8& pa2, bf16x8& pa3) {
    float ps = 0.f;
#pragma unroll
    for (int r = 0; r < 16; ++r) ps += p0[r];
#pragma unroll
    for (int r = 0; r < 16; ++r) ps += p1[r];
    l_reg += ps;
#define PK4(P, BASE, OUT) do { unsigned a0 = cvt_pk_bf16(P[BASE + 0], P[BASE + 1]), a1 = cvt_pk_bf16(P[BASE + 2], P[BASE + 3]);   \
    unsigned b0 = cvt_pk_bf16(P[BASE + 4], P[BASE + 5]), b1 = cvt_pk_bf16(P[BASE + 6], P[BASE + 7]);                              \
    auto r0 = __builtin_amdgcn_permlane32_swap(a0, b0, false, false); auto r1 = __builtin_amdgcn_permlane32_swap(a1, b1, false, false); \
    u32x4 w = {r0[0], r1[0], r0[1], r1[1]}; OUT = *reinterpret_cast<bf16x8*>(&w); } while (0)
    PK4(p0, 0, pa0); PK4(p0, 8, pa1); PK4(p1, 0, pa2); PK4(p1, 8, pa3);
#undef PK4
}

__device__ __forceinline__ void attn_unit(const bf16_t* __restrict__ Qb, const bf16_t* __restrict__ Kh, const bf16_t* __restrict__ Vh, bf16_t* __restrict__ Ob,
                                          LAS unsigned char* lds, float MB, int tid, int nrows, int t0, int t1, float* part, float* partl) {
    const int wid = __builtin_amdgcn_readfirstlane(tid >> 6), lane = tid & 63, r32 = lane & 31, hi = lane >> 5;
    LAS unsigned char* V_lds = lds + LDS_V; LAS unsigned char* K_lds = lds + LDS_K;
    LAS float* li_l = (LAS float*)(lds + LDS_WS) + wid * 64;
    const bool act = wid * 32 < nrows;
    float l_reg = 0.f; f32x16 o[4] = {}; bf16x8 qr[QREG];
    LAS unsigned char* qt = lds + LDS_QT + wid * ((12 - QREG) * 1024) + lane * 16;
    const unsigned qo = (unsigned)((wid * 32 + r32) * LDQ + hi * 8) * 2u;
#pragma unroll
    for (int d0 = 0; d0 < QREG; ++d0) qr[d0] = *(const bf16x8*)((const char*)Qb + qo + d0 * 32);
#pragma unroll
    for (int d0 = QREG; d0 < 12; ++d0) *(LAS bf16x8*)(qt + (d0 - QREG) * 1024) = *(const bf16x8*)((const char*)Qb + qo + d0 * 32);
    unsigned ko[3], vo[2];
#pragma unroll
    for (int i = 0; i < 3; ++i) { const int sl = tid + 512 * i, row = sl / 24, pc = sl - row * 24, ch = pc ^ ((row >> 1) & 7); ko[i] = (unsigned)(row * LDKK + ch * 8) * 2u; }
#pragma unroll
    for (int i = 0; i < 2; ++i) { const int sl = tid + 512 * i, sub = sl >> 5, kk = (sub >> 2) * 8 + ((sl >> 2) & 7), c = (sub & 3) * 32 + (sl & 3) * 8;
        const int kx = (kk & ~0xC) | ((kk & 4) << 1) | ((kk & 8) >> 1); vo[i] = (unsigned)(kx * LDV + c) * 2u; }
    const int vb0 = (int)(unsigned)(uintptr_t)V_lds + v_rd_base(lane);
    const unsigned ldw = (unsigned)wid * 1024u;
#define SDMA(k0, b) do { const char* _vp = (const char*)Vh + (size_t)(k0) * (LDV * 2); const char* _kp = (const char*)Kh + (size_t)(k0) * (LDKK * 2); \
    _Pragma("unroll") for (int _i = 0; _i < 3; ++_i) __builtin_amdgcn_global_load_lds((const unsigned*)(_kp + ko[_i]), (LAS unsigned*)(K_lds + (b) * SHM_K + _i * 8192 + ldw), 16, 0, 0); \
    _Pragma("unroll") for (int _i = 0; _i < 2; ++_i) __builtin_amdgcn_global_load_lds((const unsigned*)(_vp + vo[_i]), (LAS unsigned*)(V_lds + (b) * SHM_V + _i * 8192 + ldw), 16, 0, 0); } while (0)
    f32x16 p0, p1; bf16x8 pa0, pa1, pa2, pa3;
    SDMA(t0 * KVBLK, 0); asm volatile("s_waitcnt vmcnt(0)" ::: "memory"); __syncthreads();
    for (int j = t0; j < t1; ++j) {
        const int b = (j - t0) & 1; const bool more = (j + 1 < t1);
        if (more) { if (b) SDMA((j + 1) * KVBLK, 0); else SDMA((j + 1) * KVBLK, 1); }
        if (act) {
        SBAR(); qkt(p0, p1, K_lds + b * SHM_K, qr, qt, r32, hi);
        expP(p0, p1, MB);
        if (j == NT - 1) maskLast(p0, p1);
        finishP(p0, p1, l_reg, pa0, pa1, pa2, pa3); SBAR();
        pv_d0(o, vb0 + b * SHM_V, pa0, pa1, pa2, pa3);
        }
        asm volatile("s_waitcnt vmcnt(0)" ::: "memory");
        __syncthreads();
    }
    if (act && part) {
        l_reg += shx(l_reg, 32, lane);
        if (hi == 0 && r32 < 16) partl[r32] = l_reg;
#pragma unroll
        for (int r = 0; r < 8; ++r) {
#pragma unroll
            for (int d0 = 0; d0 < 4; ++d0) part[crow(r, hi) * 128 + d0 * 32 + r32] = o[d0][r]; }
    } else if (act) {
    l_reg += shx(l_reg, 32, lane);
    if (hi == 0) li_l[r32] = l_reg;
    asm volatile("s_waitcnt lgkmcnt(0)" ::: "memory");
    float rli[16];
#pragma unroll
    for (int r = 0; r < 16; ++r) rli[r] = __builtin_amdgcn_rcpf(li_l[crow(r, hi)]);
    int r32e = r32; asm volatile("" : "+v"(r32e));
    const unsigned ob = (unsigned)((wid * 32) * LDO + r32e) * 2u;
#pragma unroll
    for (int r = 0; r < 16; ++r) { const int orow = crow(r, hi);
        if (wid * 32 + orow < nrows) {
#pragma unroll
        for (int d0 = 0; d0 < 4; ++d0) *(bf16_t*)((char*)Ob + ob + (unsigned)(orow * LDO + d0 * 32) * 2u) = to_bf1(o[d0][r] * rli[r]); } }
    }
    __syncthreads();
#undef SDMA
}
}


#define XB_TMO      128
#define XB_XCNT(j)  (256  + 64 * (j))
#define XB_XSUB(j)  (1280 + 64 * (j))
#define XB_XGEN(j)  (2304 + 64 * (j))
#define XB_TOP      3328
#define XB_TOPGEN   3392
#define XCD_BAR_WORDS 3456
#define XB_SPIN_CAP (1u << 22)
static_assert(XCD_BAR_WORDS * 4 <= CTL_BYTES, "barrier words");
__device__ __forceinline__ unsigned xb_ld(unsigned* p)              { return __hip_atomic_load(p, __ATOMIC_RELAXED, __HIP_MEMORY_SCOPE_AGENT); }
__device__ __forceinline__ unsigned xb_add(unsigned* p, unsigned v) { return __hip_atomic_fetch_add(p, v, __ATOMIC_RELAXED, __HIP_MEMORY_SCOPE_AGENT); }
__device__ __forceinline__ unsigned xb_xcc_id() { return (unsigned)__builtin_amdgcn_s_getreg((3 << 11) | 20) & 0xFu; }
#define XB_SPIN(cond, bar) do { unsigned _sp = 0; while (cond) { __builtin_amdgcn_s_sleep(1); \
    if ((++_sp & 255u) == 0u) { if (xb_ld(&(bar)[XB_TMO])) break; if (_sp > XB_SPIN_CAP) { atomicAdd(&(bar)[XB_TMO], 1u); break; } } } } while (0)
struct XcdBarrier { unsigned* bar; unsigned x; volatile LAS unsigned* st; };
__device__ __forceinline__ void xcd_barrier_complete(unsigned* bar, unsigned x, unsigned& nloc, unsigned& nx) {
    const unsigned G = gridDim.x * gridDim.y * gridDim.z;
    unsigned sum, cnt, mine, sp = 0u;
    for (;;) {
        sum = 0u; cnt = 0u; mine = 0u;
#pragma unroll
        for (unsigned j = 0; j < 16; ++j) { const unsigned c = xb_ld(&bar[XB_XCNT(j)]); sum += c; cnt += (c > 0u) ? 1u : 0u; mine = (j == x) ? c : mine; }
        if (sum == G) break;
        __builtin_amdgcn_s_sleep(1);
        if ((++sp & 255u) == 0u) { if (xb_ld(&bar[XB_TMO])) break; if (sp > XB_SPIN_CAP) { atomicAdd(&bar[XB_TMO], 1u); break; } }
    }
    nloc = mine > 0u ? mine : 1u; nx = cnt > 0u ? cnt : 1u;
}
__device__ __forceinline__ void xcd_barrier(const XcdBarrier& b, int tid) {
    asm volatile("s_waitcnt vmcnt(0)" ::: "memory");
    __syncthreads();
    if (tid == 0) {
        unsigned* bar = b.bar;
        __builtin_amdgcn_s_waitcnt(0);
        unsigned nloc = b.st[0], nx = b.st[1];
        if (nloc == 0u) { xcd_barrier_complete(bar, b.x, nloc, nx); b.st[0] = nloc; b.st[1] = nx; }
        const unsigned old = xb_add(&bar[XB_XSUB(b.x)], 1u);
        const unsigned gen = old / nloc;
        if (old + 1u == (gen + 1u) * nloc) {
            __builtin_amdgcn_fence(__ATOMIC_RELEASE, "agent");
            asm volatile("s_waitcnt vmcnt(0)" ::: "memory");
            const unsigned og = xb_add(&bar[XB_TOP], 1u);
            const unsigned tg = og / nx;
            if (og + 1u == (tg + 1u) * nx) xb_add(&bar[XB_TOPGEN], 1u);
            else XB_SPIN(xb_ld(&bar[XB_TOPGEN]) == tg, bar);
            __builtin_amdgcn_fence(__ATOMIC_ACQUIRE, "agent");
            xb_add(&bar[XB_XGEN(b.x)], 1u);
            asm volatile("s_waitcnt vmcnt(0)" ::: "memory");
        } else {
            XB_SPIN(xb_ld(&bar[XB_XGEN(b.x)]) == gen, bar);
            __builtin_amdgcn_fence(__ATOMIC_ACQUIRE, "agent");
            asm volatile("s_waitcnt vmcnt(0)" ::: "memory");
        }
    }
    __syncthreads();
}

#ifndef REP_MASK
#define REP_MASK 0
#endif
#ifndef ATT_REPEAT
#define ATT_REPEAT 1
#endif
constexpr int LDS_TOTAL = 147456;
static_assert(pg8::STAGE_BYTES <= LDS_TOTAL && att::LDS_BYTES <= LDS_TOTAL, "LDS");
struct Args { const float* in[19]; float* out; unsigned char* ws; int ph_lo, ph_hi; };
enum { I_X = 0, I_META, I_GMIX, I_WIN, I_GQA, I_GKVA, I_WUQ, I_WUKV, I_GQ, I_GK, I_CONVC, I_WPA, I_WPB, I_WPC, I_WO, I_GFFN, I_WUP, I_CONVF, I_WDOWN };

__device__ __forceinline__ void tr_item(const float* __restrict__ W, int K, int N, bf16_t* __restrict__ WT, int dst_row0, int src_col0, int k0, LAS float* scr, int lane) {
    if (src_col0 >= 0) {
        const float* wp = W + (size_t)(k0 + (lane >> 5)) * N + src_col0 + (lane & 31);
        float t[32];
#pragma unroll
        for (int i = 0; i < 32; ++i) t[i] = __builtin_nontemporal_load(wp + (size_t)(2 * i) * N);
#pragma unroll
        for (int i = 0; i < 32; ++i) scr[(2 * i + (lane >> 5)) * 33 + (lane & 31)] = t[i];
    } else {
#pragma unroll 8
        for (int i = 0; i < 32; ++i) { const int kk = 2 * i + (lane >> 5); scr[kk * 33 + (lane & 31)] = 0.f; }
    }
    LDS_WAIT(); asm volatile("" ::: "memory");
    const int c = lane & 7;
#pragma unroll
    for (int j = 0; j < 4; ++j) { const int n = (lane >> 3) + 8 * j; const LAS float* s = scr + (8 * c) * 33 + n;
        u32x4 o; o.x = cvt_pk_bf16(s[0 * 33], s[1 * 33]); o.y = cvt_pk_bf16(s[2 * 33], s[3 * 33]); o.z = cvt_pk_bf16(s[4 * 33], s[5 * 33]); o.w = cvt_pk_bf16(s[6 * 33], s[7 * 33]);
        *(u32x4*)(WT + (size_t)(dst_row0 + n) * K + k0 + 8 * c) = o; }
    LDS_WAIT(); asm volatile("" ::: "memory");
}
__device__ __forceinline__ bool conv_plain(int& it, const float* W, int K, int N, bf16_t* WT, LAS float* scr, int lane) {
    const int nblk = N / 32, items = (K / 64) * nblk;
    if (it < items) { const int kb = it / nblk, nb = it - kb * nblk; tr_item(W, K, N, WT, nb * 32, nb * 32, kb * 64, scr, lane); return true; }
    it -= items; return false;
}

__global__ void __launch_bounds__(512, 2) mk_fwd(Args a) {
    extern __shared__ __attribute__((aligned(16))) unsigned char lds_raw[];
    LAS unsigned char* lds = (LAS unsigned char*)lds_raw;
    cg::grid_group grid = cg::this_grid();
    const int wave_s = __builtin_amdgcn_readfirstlane((int)threadIdx.x >> 6);
    volatile LAS unsigned* xst = (volatile LAS unsigned*)(lds + LDS_TOTAL - 64);
    if (threadIdx.x < 2) xst[threadIdx.x] = 0u;
    __syncthreads();
    XcdBarrier xbar; xbar.bar = (unsigned*)(a.ws + O_CTL); xbar.x = xb_xcc_id(); xbar.st = xst;
    if (threadIdx.x == 0) (void)xb_add(&xbar.bar[XB_XCNT(xbar.x)], 1u);
    for (int ph = a.ph_lo; ph < a.ph_hi; ++ph) {
        if (ph > a.ph_lo) { if (ph == a.ph_lo + 1) grid.sync(); else xcd_barrier(xbar, (int)threadIdx.x); }
        for (int rep = 0; rep <= ((REP_MASK >> (ph % 13)) & 1); ++rep) {
        int lane; asm volatile("v_mbcnt_lo_u32_b32 %0, -1, 0\n\tv_mbcnt_hi_u32_b32 %0, -1, %0" : "=v"(lane));
        unsigned char* ws = a.ws; asm volatile("" : "+s"(ws));
        const int wave = wave_s, tid = wave * 64 + lane;
        const int G = gridDim.x, bx = blockIdx.x, gw = bx * 8 + wave, NGW = G * 8;
        bf16_t* W0 = (bf16_t*)(ws + O_W0); unsigned char* W1 = ws + O_W1;
        bf16_t* CH = (bf16_t*)(ws + O_CH); bf16_t* SH = (bf16_t*)(ws + O_SH); bf16_t* CS = (bf16_t*)(ws + O_CS); float* ROPE = (float*)(ws + O_ROPE);
        float* H = (float*)(ws + O_H); bf16_t* X = (bf16_t*)(ws + O_X); bf16_t* PA = (bf16_t*)(ws + O_PA); bf16_t* PG = (bf16_t*)(ws + O_PG);
        bf16_t* KR = (bf16_t*)(ws + O_KR); bf16_t* KV = (bf16_t*)(ws + O_KV); bf16_t* KP = (bf16_t*)(ws + O_KP); bf16_t* CC = (bf16_t*)(ws + O_CC);
        bf16_t* EO = (bf16_t*)(ws + O_EO); float* MG = (float*)(ws + O_MG); bf16_t* MB = (bf16_t*)(ws + O_MB);
        bf16_t* Q = (bf16_t*)(ws + O_Q); bf16_t* ET = (bf16_t*)(ws + O_ET); bf16_t* UW = (bf16_t*)(ws + O_UW);
        bf16_t* CQN = X; bf16_t* CKVN = X + (size_t)MP * QL; bf16_t* AO = X; bf16_t* U = PA; bf16_t* GT = KV;
        LAS float* scr = (LAS float*)(lds + wave * 16384);

        const int l = ph / 13, k = ph - l * 13;
        if (k == 0) {
            if (l == 0) {
                const int gt = bx * 512 + tid, NTH = G * 512;
                { const f32x4 zf = pg8::zero4(); const u32x4 z4 = {__float_as_uint(zf[0]), __float_as_uint(zf[1]), __float_as_uint(zf[2]), __float_as_uint(zf[3])};
                for (int idx = gt; idx < 48 * (NKV / 8); idx += NTH) *(u32x4*)(KV + (size_t)LSEQ * NKV + (size_t)idx * 8) = z4;
                for (int idx = gt; idx < 48 * (NQ / 8); idx += NTH) *(u32x4*)(KP + (size_t)LSEQ * NQ + (size_t)idx * 8) = z4; }
                for (int idx = gt; idx < LSEQ * 32; idx += NTH) { const int pos = idx >> 5, i = idx & 31;
                    const float inv = __builtin_amdgcn_exp2f(-(float)i * (13.287712379549449f / 32.f)); const float ang = (float)pos * inv;
                    double rv = (double)ang * 0.15915494309189535; rv -= __builtin_floor(rv); const float rf = (float)rv;
                    ROPE[pos * 64 + i] = __builtin_amdgcn_cosf(rf); ROPE[pos * 64 + 32 + i] = __builtin_amdgcn_sinf(rf); }
                for (int idx = gt; idx < 2 * 65536; idx += NTH) { const int cs = idx >> 16, m = (idx >> 8) & 255, c = idx & 255; const float rf = (float)((m * c) & 255) * (1.f / 256.f);
                    CS[idx] = to_bf1(cs ? __builtin_amdgcn_sinf(rf) : __builtin_amdgcn_cosf(rf)); }
                for (int idx = gt; idx < MH * (MH / 8); idx += NTH) { const int kf = idx / (MH / 8), lf0 = (idx - kf * (MH / 8)) * 8;
                    int t = (int)(((long)kf * lf0) % LSEQ); float cv[8], sv[8];
#pragma unroll
                    for (int j = 0; j < 8; ++j) { const bool ok = (kf <= HF) && (lf0 + j <= HF); const float rf = (float)t * (1.f / (float)LSEQ);
                        cv[j] = ok ? __builtin_amdgcn_cosf(rf) : 0.f; sv[j] = ok ? __builtin_amdgcn_sinf(rf) : 0.f; t += kf; if (t >= LSEQ) t -= LSEQ; }
                    u32x4 wc_, ws_; wc_.x = cvt_pk_bf16(cv[0], cv[1]); wc_.y = cvt_pk_bf16(cv[2], cv[3]); wc_.z = cvt_pk_bf16(cv[4], cv[5]); wc_.w = cvt_pk_bf16(cv[6], cv[7]);
                    ws_.x = cvt_pk_bf16(sv[0], sv[1]); ws_.y = cvt_pk_bf16(sv[2], sv[3]); ws_.z = cvt_pk_bf16(sv[4], sv[5]); ws_.w = cvt_pk_bf16(sv[6], sv[7]);
                    *(u32x4*)(CH + (size_t)kf * MH + lf0) = wc_; *(u32x4*)(SH + (size_t)kf * MH + lf0) = ws_; }
            }
            {
                const float* win = a.in[I_WIN] + (size_t)l * DM * NIN;
                const int nblk_in = NPIN / 32, items_in = (DM / 64) * nblk_in;
                const int items_small = (QL / 64) * (NQ / 32) + (KVL / 64) * (NKV / 32) + (1024 / 64) * (DM / 32) * 2 + (DM / 64) * (DM / 32) * 2;
                for (int it0 = gw; it0 < items_in + items_small; it0 += NGW) {
                    int it = it0;
                    if (it < items_in) { const int kb = it / nblk_in, nb = it - kb * nblk_in; const int j = nb * 32; int src;
                        if (j < 2304) src = j; else if (j < 5376) src = j + 64; else if (j < 5440) src = 2304 + (j - 5376); else if (j < 5632) src = -1; else src = 5440 + (j - 5632);
                        tr_item(win, DM, NIN, W0, j, src, kb * 64, scr, lane); continue; }
                    it -= items_in;
                    if (conv_plain(it, a.in[I_WUQ] + (size_t)l * QL * NQ, QL, NQ, (bf16_t*)(W1 + OW_UQ), scr, lane)) continue;
                    if (conv_plain(it, a.in[I_WUKV] + (size_t)l * KVL * NKV, KVL, NKV, (bf16_t*)(W1 + OW_UKV), scr, lane)) continue;
                    if (conv_plain(it, a.in[I_WPA] + (size_t)l * 1024 * DM, 1024, DM, (bf16_t*)(W1 + OW_PA), scr, lane)) continue;
                    if (conv_plain(it, a.in[I_WPB] + (size_t)l * DM * DM, DM, DM, (bf16_t*)(W1 + OW_PB), scr, lane)) continue;
                    if (conv_plain(it, a.in[I_WPC] + (size_t)l * 1024 * DM, 1024, DM, (bf16_t*)(W1 + OW_PC), scr, lane)) continue;
                    conv_plain(it, a.in[I_WO] + (size_t)l * DM * DM, DM, DM, (bf16_t*)(W1 + OW_O), scr, lane);
                }
            }
            {
                const float* gm = a.in[I_GMIX] + (size_t)l * DM;
                for (int r = gw; r < LSEQ; r += NGW) {
                    f32x4 v[8]; float s = 0.f;
                    if (l == 0) {
                        const float* src = r < LREAL ? a.in[I_X] + (size_t)r * DM : (r < LSEQ ? a.in[I_META] + (size_t)(r - LREAL) * DM : nullptr);
#pragma unroll
                        for (int j = 0; j < 8; ++j) { v[j] = src ? *(const f32x4*)(src + (lane + 64 * j) * 4) : (f32x4){0.f, 0.f, 0.f, 0.f}; }
                    } else {
#pragma unroll
                        for (int j = 0; j < 8; ++j) { const u32x2 hw = *(const u32x2*)((const bf16_t*)H + (size_t)r * DM + (lane + 64 * j) * 4); v[j] = (f32x4){bf_lo(hw.x), bf_hi(hw.x), bf_lo(hw.y), bf_hi(hw.y)}; }
                    }
#pragma unroll
                    for (int j = 0; j < 8; ++j) s += (v[j].x * v[j].x + v[j].y * v[j].y) + (v[j].z * v[j].z + v[j].w * v[j].w);
                    const float rs = __builtin_amdgcn_rsqf(wave_sum(s, lane) * (1.f / DM) + EPS);
#pragma unroll
                    for (int j = 0; j < 8; ++j) { const f32x4 g = *(const f32x4*)(gm + (lane + 64 * j) * 4); const f32x4 y = v[j] * rs * g;
                        u32x2 w; w.x = cvt_pk_bf16(y.x, y.y); w.y = cvt_pk_bf16(y.z, y.w); *(u32x2*)(X + (size_t)r * DM + (lane + 64 * j) * 4) = w; }
                }
            }
        } else if (k == 2) {
            const float* gqa = a.in[I_GQA] + (size_t)l * QL; const float* gkva = a.in[I_GKVA] + (size_t)l * KVL; const float* cw = a.in[I_CONVC] + (size_t)l * 3 * 1024;
            for (int r = gw; r < LSEQ; r += NGW) {
                const bf16_t* pr = PA + (size_t)r * NPA;
                { u32x2 w[3]; float s = 0.f;
#pragma unroll
                  for (int j = 0; j < 3; ++j) { w[j] = *(const u32x2*)(pr + 1024 + (lane + 64 * j) * 4); const float a0 = bf_lo(w[j].x), a1 = bf_hi(w[j].x), a2 = bf_lo(w[j].y), a3 = bf_hi(w[j].y); s += (a0 * a0 + a1 * a1) + (a2 * a2 + a3 * a3); }
                  const float rs = __builtin_amdgcn_rsqf(wave_sum(s, lane) * (1.f / QL) + EPS);
#pragma unroll
                  for (int j = 0; j < 3; ++j) { const f32x4 g = *(const f32x4*)(gqa + (lane + 64 * j) * 4); u32x2 o;
                      o.x = cvt_pk_bf16(bf_lo(w[j].x) * rs * g.x, bf_hi(w[j].x) * rs * g.y); o.y = cvt_pk_bf16(bf_lo(w[j].y) * rs * g.z, bf_hi(w[j].y) * rs * g.w);
                      *(u32x2*)(CQN + (size_t)r * QL + (lane + 64 * j) * 4) = o; } }
                { u32x2 w[2]; float s = 0.f;
#pragma unroll
                  for (int j = 0; j < 2; ++j) { w[j] = *(const u32x2*)(pr + 1792 + (lane + 64 * j) * 4); const float a0 = bf_lo(w[j].x), a1 = bf_hi(w[j].x), a2 = bf_lo(w[j].y), a3 = bf_hi(w[j].y); s += (a0 * a0 + a1 * a1) + (a2 * a2 + a3 * a3); }
                  const float rs = __builtin_amdgcn_rsqf(wave_sum(s, lane) * (1.f / KVL) + EPS);
#pragma unroll
                  for (int j = 0; j < 2; ++j) { const f32x4 g = *(const f32x4*)(gkva + (lane + 64 * j) * 4); u32x2 o;
                      o.x = cvt_pk_bf16(bf_lo(w[j].x) * rs * g.x, bf_hi(w[j].x) * rs * g.y); o.y = cvt_pk_bf16(bf_lo(w[j].y) * rs * g.z, bf_hi(w[j].y) * rs * g.w);
                      *(u32x2*)(CKVN + (size_t)r * KVL + (lane + 64 * j) * 4) = o; } }
                { const int rl = row_left(r), rr = row_right(r);
                  const bf16_t* pl = PA + (size_t)(rl < 0 ? r : rl) * NPA; const bf16_t* pq = PA + (size_t)(rr < 0 ? r : rr) * NPA;
                  const float ml = rl < 0 ? 0.f : 1.f, mr = rr < 0 ? 0.f : 1.f;
#pragma unroll
                  for (int j = 0; j < 4; ++j) { const int c = (lane + 64 * j) * 4;
                      const u32x2 b = *(const u32x2*)(pr + 2304 + c);
                      const u32x2 c0 = *(const u32x2*)(pl + 3328 + c), h0 = *(const u32x2*)(pl + 4352 + c);
                      const u32x2 c1 = *(const u32x2*)(pr + 3328 + c), h1 = *(const u32x2*)(pr + 4352 + c);
                      const u32x2 c2 = *(const u32x2*)(pq + 3328 + c), h2 = *(const u32x2*)(pq + 4352 + c);
                      const f32x4 w0 = *(const f32x4*)(cw + c) * ml, w1 = *(const f32x4*)(cw + 1024 + c), w2 = *(const f32x4*)(cw + 2048 + c) * mr;
                      const float y0 = bf_lo(b.x) * (w0.x * bf_lo(c0.x) * bf_lo(h0.x) + w1.x * bf_lo(c1.x) * bf_lo(h1.x) + w2.x * bf_lo(c2.x) * bf_lo(h2.x));
                      const float y1 = bf_hi(b.x) * (w0.y * bf_hi(c0.x) * bf_hi(h0.x) + w1.y * bf_hi(c1.x) * bf_hi(h1.x) + w2.y * bf_hi(c2.x) * bf_hi(h2.x));
                      const float y2 = bf_lo(b.y) * (w0.z * bf_lo(c0.y) * bf_lo(h0.y) + w1.z * bf_lo(c1.y) * bf_lo(h1.y) + w2.z * bf_lo(c2.y) * bf_lo(h2.y));
                      const float y3 = bf_hi(b.y) * (w0.w * bf_hi(c0.y) * bf_hi(h0.y) + w1.w * bf_hi(c1.y) * bf_hi(h1.y) + w2.w * bf_hi(c2.y) * bf_hi(h2.y));
                      u32x2 o; o.x = cvt_pk_bf16(y0, y1); o.y = cvt_pk_bf16(y2, y3); *(u32x2*)(CC + (size_t)r * 1024 + c) = o; } }
            }
            for (int lf = gw; lf < MH; lf += NGW) {
                const bool v = lf <= HF, pr2 = lf > 0 && lf < HF;
                const bf16_t* p1 = PA + (size_t)(v ? phys_of(lf) : 0) * NPA; const bf16_t* p2 = PA + (size_t)(pr2 ? phys_of(LSEQ - lf) : 0) * NPA;
#pragma unroll
                for (int j = 0; j < 4; ++j) { const int c = (lane + 64 * j) * 4; u32x2 e = {0u, 0u}, o = {0u, 0u};
                    if (v) { const u32x2 x = *(const u32x2*)(p1 + c); e = x;
                        if (pr2) { const u32x2 y = *(const u32x2*)(p2 + c);
                            e.x = cvt_pk_bf16(bf_lo(x.x) + bf_lo(y.x), bf_hi(x.x) + bf_hi(y.x)); e.y = cvt_pk_bf16(bf_lo(x.y) + bf_lo(y.y), bf_hi(x.y) + bf_hi(y.y));
                            o.x = cvt_pk_bf16(bf_lo(x.x) - bf_lo(y.x), bf_hi(x.x) - bf_hi(y.x)); o.y = cvt_pk_bf16(bf_lo(x.y) - bf_lo(y.y), bf_hi(x.y) - bf_hi(y.y)); } }
                    *(u32x2*)(EO + (size_t)lf * 1024 + c) = e; *(u32x2*)(EO + (size_t)MH * 1024 + (size_t)lf * 1024 + c) = o; }
            }
        } else if (k == 4) {
            const float* gq = a.in[I_GQ] + (size_t)l * 192; const float* gk = a.in[I_GK] + (size_t)l * 192;
            const int hh = lane >> 2, qq = lane & 3;
            f32x4 gqv[6][2], gkv[6][2];
#pragma unroll
            for (int m = 0; m < 6; ++m) { gqv[m][0] = *(const f32x4*)(gq + 8 * (qq + 4 * m)); gqv[m][1] = *(const f32x4*)(gq + 8 * (qq + 4 * m) + 4);
                gkv[m][0] = *(const f32x4*)(gk + 8 * (qq + 4 * m)); gkv[m][1] = *(const f32x4*)(gk + 8 * (qq + 4 * m) + 4); }
            const float C2 = 0.07216878364870322f * 1.4426950408889634f;
            for (int r = gw; r < LSEQ; r += NGW) {
                const int pos = pos_of(r);
                const f32x4 cs0 = *(const f32x4*)(ROPE + pos * 64 + 8 * qq), cs1 = *(const f32x4*)(ROPE + pos * 64 + 8 * qq + 4);
                const f32x4 sn0 = *(const f32x4*)(ROPE + pos * 64 + 32 + 8 * qq), sn1 = *(const f32x4*)(ROPE + pos * 64 + 32 + 8 * qq + 4);
                bf16_t* qp = Q + (size_t)r * NQ + hh * 192 + 8 * qq;
                const bf16_t* kvp = KV + (size_t)r * NKV + hh * 256 + 8 * qq;
                bf16_t* kp = KP + (size_t)r * NQ + hh * 192 + 8 * qq;
                u32x4 xq[6], xk[6];
#pragma unroll
                for (int m = 0; m < 6; ++m) xq[m] = *(const u32x4*)(qp + 32 * m);
#pragma unroll
                for (int m = 0; m < 4; ++m) xk[m] = *(const u32x4*)(kvp + 32 * m);
                xk[4] = *(const u32x4*)(KR + (size_t)r * NKR + 8 * qq); xk[5] = *(const u32x4*)(KR + (size_t)r * NKR + 32 + 8 * qq);
#pragma unroll
                for (int which = 0; which < 2; ++which) {
                    f32x4 v[6][2]; float ss = 0.f;
#pragma unroll
                    for (int m = 0; m < 6; ++m) { const u32x4 w = which ? xk[m] : xq[m];
                        v[m][0] = (f32x4){bf_lo(w.x), bf_hi(w.x), bf_lo(w.y), bf_hi(w.y)}; v[m][1] = (f32x4){bf_lo(w.z), bf_hi(w.z), bf_lo(w.w), bf_hi(w.w)};
                        const f32x4 sq = v[m][0] * v[m][0] + v[m][1] * v[m][1]; ss += (sq[0] + sq[1]) + (sq[2] + sq[3]); }
                    ss += shx(ss, 1, lane); ss += shx(ss, 2, lane);
                    const float rs = __builtin_amdgcn_rsqf(ss * (1.f / 192.f) + EPS) * (which ? 1.f : C2);
#pragma unroll
                    for (int m = 0; m < 6; ++m) { v[m][0] = v[m][0] * rs * (which ? gkv[m][0] : gqv[m][0]); v[m][1] = v[m][1] * rs * (which ? gkv[m][1] : gqv[m][1]); }
                    const f32x4 a0 = v[4][0], a1 = v[4][1], b0 = v[5][0], b1 = v[5][1];
                    v[4][0] = a0 * cs0 - b0 * sn0; v[4][1] = a1 * cs1 - b1 * sn1; v[5][0] = b0 * cs0 + a0 * sn0; v[5][1] = b1 * cs1 + a1 * sn1;
                    bf16_t* op = which ? kp : qp;
#pragma unroll
                    for (int m = 0; m < 6; ++m) *(u32x4*)(op + 32 * m) = pg8::pack8(v[m][0], v[m][1]);
                }
            }
        } else if (k == 5) {
            {
                const float* gq = a.in[I_GQ] + (size_t)l * 192; const float* gk = a.in[I_GK] + (size_t)l * 192;
                float mq = fmaxf(fmaxf(fabsf(gq[lane]), fabsf(gq[64 + lane])), fabsf(gq[128 + lane])), mk = fmaxf(fmaxf(fabsf(gk[lane]), fabsf(gk[64 + lane])), fabsf(gk[128 + lane]));
#pragma unroll
                for (int o = 1; o < 64; o <<= 1) { mq = fmaxf(mq, shx(mq, o, lane)); mk = fmaxf(mk, shx(mk, o, lane)); }
                const float bound = mq * mk * 13.856406460551018f * 1.4426950408889634f;
                const float MBs = fmaxf(0.f, bound - 60.f);
                for (int rep = 0; rep < ATT_REPEAT; ++rep) {
                float* PM = (float*)(ws + O_PM);
                const int nr = (512 - bx + G - 1) / G, mp0 = (G >= 136 + 16 * NMP) ? bx - 136 : bx, mstep = (G >= 136 + 16 * NMP) ? G : G;
                for (int it = 0;; ++it) { const bool mt = it >= nr; const int mp = mp0 + (it - nr) * mstep;
                    if (mt && (mp < 0 || mp >= 16 * NMP)) break;
                    const int un = bx + it * G;
                    const int h = mt ? mp / NMP : (un & 7) | ((un >> 8) << 3), qrow = mt ? LREAL : ((un >> 3) & 31) * 256, pc = mt ? mp - h * NMP : 0;
                    const int t0 = mt ? (pc * att::NT) / NMP : 0, t1 = mt ? ((pc + 1) * att::NT) / NMP : att::NT;
                    att::attn_unit(Q + (size_t)qrow * NQ + h * 192, KP + h * 192, KV + h * 256 + 128, AO + (size_t)qrow * DM + h * 128, lds, MBs, tid, mt ? 16 : 256, t0, t1,
                                   mt ? PM + (size_t)mp * 16 * 128 : nullptr, mt ? PM + PM_L + (size_t)mp * 16 : nullptr); }
                }
            }
            {
                pg8::Desc d{}; d.A = CH; d.Bt = ET; d.M = MH; d.N = 1024; d.K = 4224;     d.lda = MH; d.ldb = MH; d.nb = 2; d.nb2s = 0; d.sA1 = (long)MH * MH; d.sB1 = (long)1024 * MH;
                d.epi = pg8::EPI_BF16; d.o0 = UW; d.ldc = 1024; d.sO = (long)MH * 1024; d.scale = 0.0006898525f;
                pg8::gemm_phase(lds, d, G, bx, tid);
            }
            if (bx >= 136 || G <= 136) {
                const int cw0 = (G > 136 ? bx - 136 : bx) * 8 + wave, ncw = (G > 136 ? G - 136 : G) * 8;
                const int items_up = (DM / 64) * (NUP / 32), items_dn = (DFF / 64) * (DM / 32);
                for (int it0 = cw0; it0 < items_up + items_dn; it0 += ncw) { int it = it0;
                    if (conv_plain(it, a.in[I_WUP] + (size_t)l * DM * NUP, DM, NUP, W0, scr, lane)) continue;
                    conv_plain(it, a.in[I_WDOWN] + (size_t)l * DFF * DM, DFF, DM, (bf16_t*)(ws + O_WD), scr, lane); }
            }
        } else if (k == 6) {
            { const float* PM = (const float*)(ws + O_PM);
              for (int it = gw; it < 16 * 16; it += NGW) { const int h = it >> 4, row = it & 15; float s0 = 0.f, s1 = 0.f, ls = 0.f;
#pragma unroll
                  for (int p = 0; p < NMP; ++p) { const float* pp = PM + ((size_t)(h * NMP + p) * 16 + row) * 128; s0 += pp[lane]; s1 += pp[64 + lane]; ls += PM[PM_L + (h * NMP + p) * 16 + row]; }
                  const float rl = 1.f / ls; bf16_t* op = AO + (size_t)(LREAL + row) * DM + h * 128;
                  op[lane] = to_bf1(s0 * rl); op[64 + lane] = to_bf1(s1 * rl); } }
            for (int r = gw; r < LSEQ; r += NGW) {
                const bool v = r < LSEQ; const int kk = v ? pos_of(r) : 0; const bool up = kk > HF; const int kf = up ? LSEQ - kk : kk;
                const bf16_t* u = UW + (size_t)kf * 1024; const bf16_t* w = UW + (size_t)MH * 1024 + (size_t)kf * 1024;
#pragma unroll
                for (int j = 0; j < 4; ++j) { const int c = (lane + 64 * j) * 4; u32x2 o = {0u, 0u};
                    if (v) { const u32x2 x = *(const u32x2*)(u + c), y = *(const u32x2*)(w + c); const float sg = up ? 1.f : -1.f;
                        o.x = cvt_pk_bf16(bf_lo(x.x) + sg * bf_lo(y.x), bf_hi(x.x) + sg * bf_hi(y.x)); o.y = cvt_pk_bf16(bf_lo(x.y) + sg * bf_lo(y.y), bf_hi(x.y) + sg * bf_hi(y.y)); }
                    *(u32x2*)(CC + (size_t)r * 1024 + c) = o; }
            }
        } else if (k == 9) {
            {
                const float* gm = a.in[I_GFFN] + (size_t)l * DM;
                for (int r = gw; r < LSEQ; r += NGW) {
                    f32x4 v[8]; float s = 0.f;
#pragma unroll
                    for (int j = 0; j < 8; ++j) { const u32x2 hw = *(const u32x2*)((const bf16_t*)H + (size_t)r * DM + (lane + 64 * j) * 4); v[j] = (f32x4){bf_lo(hw.x), bf_hi(hw.x), bf_lo(hw.y), bf_hi(hw.y)}; s += (v[j].x * v[j].x + v[j].y * v[j].y) + (v[j].z * v[j].z + v[j].w * v[j].w); }
                    const float rs = __builtin_amdgcn_rsqf(wave_sum(s, lane) * (1.f / DM) + EPS);
#pragma unroll
                    for (int j = 0; j < 8; ++j) { const f32x4 g = *(const f32x4*)(gm + (lane + 64 * j) * 4); const f32x4 y = v[j] * rs * g;
                        u32x2 w; w.x = cvt_pk_bf16(y.x, y.y); w.y = cvt_pk_bf16(y.z, y.w); *(u32x2*)(X + (size_t)r * DM + (lane + 64 * j) * 4) = w; }
                }
            }
        } else if (k == 11) {
            const float* cw = a.in[I_CONVF] + (size_t)l * 3 * NUP;
            for (int task = gw; task < 11 * 129; task += NGW) {
                const int cch = task % 11, l0 = (task / 11) * 64, l1 = (l0 + 64 < LSEQ) ? l0 + 64 : LSEQ;
                const int c = cch * 512 + lane * 8;
                f32x4 wt[3][2][2];
#pragma unroll
                for (int t = 0; t < 3; ++t)
#pragma unroll
                    for (int p = 0; p < 2; ++p) { wt[t][p][0] = *(const f32x4*)(cw + t * NUP + p * DFF + c); wt[t][p][1] = *(const f32x4*)(cw + t * NUP + p * DFF + c + 4); }
                for (int lb = l0; lb < l1; lb += 4) {
                    u32x4 x[6][2];
#pragma unroll
                    for (int i = 0; i < 6; ++i) { const int lg = lb - 1 + i; const bool ok = lg >= 0 && lg < LSEQ; const bf16_t* p = U + (size_t)(ok ? phys_of(lg) : 0) * NUP + c;
                        x[i][0] = *(const u32x4*)p; x[i][1] = *(const u32x4*)(p + DFF);
                        if (!ok) { x[i][0] = (u32x4){0u, 0u, 0u, 0u}; x[i][1] = (u32x4){0u, 0u, 0u, 0u}; } }
#pragma unroll
                    for (int i = 0; i < 4; ++i) { const int lg = lb + i; if (lg < l1) {
                        f32x4 av[2], bv[2];
#pragma unroll
                        for (int hh = 0; hh < 2; ++hh) {
                            f32x4 x0, x1, x2, y0, y1, y2;
                            const unsigned a0 = hh ? x[i][0].z : x[i][0].x, a1 = hh ? x[i][0].w : x[i][0].y, b0 = hh ? x[i + 1][0].z : x[i + 1][0].x, b1 = hh ? x[i + 1][0].w : x[i + 1][0].y, c0 = hh ? x[i + 2][0].z : x[i + 2][0].x, c1 = hh ? x[i + 2][0].w : x[i + 2][0].y;
                            x0 = (f32x4){bf_lo(a0), bf_hi(a0), bf_lo(a1), bf_hi(a1)}; x1 = (f32x4){bf_lo(b0), bf_hi(b0), bf_lo(b1), bf_hi(b1)}; x2 = (f32x4){bf_lo(c0), bf_hi(c0), bf_lo(c1), bf_hi(c1)};
                            const unsigned d0 = hh ? x[i][1].z : x[i][1].x, d1 = hh ? x[i][1].w : x[i][1].y, e0 = hh ? x[i + 1][1].z : x[i + 1][1].x, e1 = hh ? x[i + 1][1].w : x[i + 1][1].y, f0 = hh ? x[i + 2][1].z : x[i + 2][1].x, f1 = hh ? x[i + 2][1].w : x[i + 2][1].y;
                            y0 = (f32x4){bf_lo(d0), bf_hi(d0), bf_lo(d1), bf_hi(d1)}; y1 = (f32x4){bf_lo(e0), bf_hi(e0), bf_lo(e1), bf_hi(e1)}; y2 = (f32x4){bf_lo(f0), bf_hi(f0), bf_lo(f1), bf_hi(f1)};
                            av[hh] = wt[0][0][hh] * x0 + wt[1][0][hh] * x1 + wt[2][0][hh] * x2;
                            bv[hh] = wt[0][1][hh] * y0 + wt[1][1][hh] * y1 + wt[2][1][hh] * y2; }
                        u32x4 o;
                        o.x = cvt_pk_bf16(av[0][0] * sigm(av[0][0]) * bv[0][0], av[0][1] * sigm(av[0][1]) * bv[0][1]); o.y = cvt_pk_bf16(av[0][2] * sigm(av[0][2]) * bv[0][2], av[0][3] * sigm(av[0][3]) * bv[0][3]);
                        o.z = cvt_pk_bf16(av[1][0] * sigm(av[1][0]) * bv[1][0], av[1][1] * sigm(av[1][1]) * bv[1][1]); o.w = cvt_pk_bf16(av[1][2] * sigm(av[1][2]) * bv[1][2], av[1][3] * sigm(av[1][3]) * bv[1][3]);
                        *(u32x4*)(GT + (size_t)phys_of(lg) * DFF + c) = o; } }
                }
            }
        } else {
            const int ng = (k == 3) ? 4 : (k == 7 ? 2 : 1);
            for (int gi = 0; gi < ng; ++gi) {
                pg8::Desc d{}; d.nb = 1; d.nb2s = 0; d.scale = 1.f;
                if (k == 1) { d.A = X; d.Bt = W0; d.M = MP; d.N = NPIN; d.K = DM; d.lda = DM; d.ldb = DM; d.epi = pg8::EPI_PIN; d.o0 = PA; d.o1 = KR; d.o2 = PG; }
                else if (k == 3 && gi == 0) { d.A = CQN; d.Bt = (bf16_t*)(W1 + OW_UQ); d.M = MP; d.N = NQ; d.K = QL; d.lda = QL; d.ldb = QL; d.epi = pg8::EPI_BF16; d.o0 = Q; d.ldc = NQ; }
                else if (k == 3 && gi == 1) { d.A = CKVN; d.Bt = (bf16_t*)(W1 + OW_UKV); d.M = MP; d.N = NKV; d.K = KVL; d.lda = KVL; d.ldb = KVL; d.epi = pg8::EPI_BF16; d.o0 = KV; d.ldc = NKV; }
                else if (k == 3 && gi == 2) { d.A = CS; d.Bt = EO; d.M = 256; d.N = MH; d.K = 256; d.lda = 256; d.ldb = 1024; d.nb = 8; d.nb2s = 2; d.sA1 = 65536; d.sA2 = 0; d.sB1 = (long)MH * 1024; d.sB2 = 256;
                    d.epi = pg8::EPI_BF16; d.o0 = ET; d.ldc = MH; d.sO = (long)256 * MH; }
                else if (k == 3 && gi == 3) { d.A = CC; d.Bt = (bf16_t*)(W1 + OW_PC); d.M = MP; d.N = DM; d.K = 1024; d.lda = 1024; d.ldb = 1024; d.epi = pg8::EPI_MERGE0; d.o0 = MG; d.o1 = MB; d.gate = PG + 4096; }
                else if (k == 7 && gi == 0) { d.A = AO; d.Bt = (bf16_t*)(W1 + OW_PB); d.M = MP; d.N = DM; d.K = DM; d.lda = DM; d.ldb = DM; d.epi = pg8::EPI_MERGE1; d.o0 = MG; d.o1 = MB; d.gate = PG + 2048; }
                else if (k == 7 && gi == 1) { d.A = CC; d.Bt = (bf16_t*)(W1 + OW_PA); d.M = MP; d.N = DM; d.K = 1024; d.lda = 1024; d.ldb = 1024; d.epi = pg8::EPI_MERGE2; d.o0 = MG; d.o1 = MB; d.gate = PG; }
                else if (k == 8) { d.A = MB; d.Bt = (bf16_t*)(W1 + OW_O); d.M = MP; d.N = DM; d.K = DM; d.lda = DM; d.ldb = DM; d.epi = pg8::EPI_RESID; d.o0 = H; d.o1 = a.out;
                    d.o2 = (void*)a.in[I_X]; d.gate = (const bf16_t*)a.in[I_META]; d.ldc = (l == 0); }
                else if (k == 10) { d.A = X; d.Bt = W0; d.M = MP; d.N = NUP; d.K = DM; d.lda = DM; d.ldb = DM; d.epi = pg8::EPI_BF16; d.o0 = U; d.ldc = NUP; }
                else { d.A = GT; d.Bt = (bf16_t*)(ws + O_WD); d.M = MP; d.N = DM; d.K = DFF; d.lda = DFF; d.ldb = DFF; d.epi = (l == 1) ? pg8::EPI_OUT : pg8::EPI_RESID; d.o0 = H; d.o1 = a.out; d.ldc = 0; }
                const bool tok = (d.M == MP);
                if (tok) d.M = LREAL;
                const int rotE = (k == 3 && gi == 2) ? 128 : 0, rotS = (k == 3 && gi == 3) ? 128 : 0;
                pg8::gemm_phase(lds, d, G, (bx + G - rotE) % G, tid);
                if (tok) { const int rem = ((d.M / 256) * (d.N / 256)) % G;
                    pg8::skinny_phase(lds, d, G - rem, rem ? bx - rem : (bx + G - rotS) % G, wave, lane); }
            }
        }
        }
    }
}

#ifndef MK_SPLIT
#define MK_SPLIT 0
#endif
extern "C" void kernel_launch(void* const* d_in, const int* in_sizes, int n_in, void* d_out, int out_size, void* d_ws, size_t ws_size, hipStream_t stream) {
    static int grid = 0;
    if (grid == 0) {
        if (n_in != 19 || ws_size < WS_END || out_size != LREAL * DM) { fprintf(stderr, "kernel_launch: unexpected shapes: n_in %d out %d ws %zu (need %zu)\n", n_in, out_size, ws_size, (size_t)WS_END); grid = -1; return; }
        int dev = 0, cus = 0, per_cu = 0;
        hipGetDevice(&dev); hipDeviceGetAttribute(&cus, hipDeviceAttributeMultiprocessorCount, dev);
        if (hipFuncSetAttribute((const void*)mk_fwd, hipFuncAttributeMaxDynamicSharedMemorySize, LDS_TOTAL) != hipSuccess) { fprintf(stderr, "kernel_launch: hipFuncSetAttribute failed\n"); grid = -1; return; }
        if (hipOccupancyMaxActiveBlocksPerMultiprocessor(&per_cu, (const void*)mk_fwd, 512, LDS_TOTAL) != hipSuccess || per_cu < 1) { fprintf(stderr, "kernel_launch: occupancy query says %d\n", per_cu); per_cu = 1; }
        (void)hipGetLastError();
        grid = cus;
    }
    if (grid < 0) return;
    if (hipMemsetAsync((char*)d_ws + O_CTL, 0, CTL_BYTES, stream) != hipSuccess) { fprintf(stderr, "kernel_launch: memset of the barrier words failed\n"); return; }
    Args a{};
    for (int i = 0; i < 19; ++i) a.in[i] = (const float*)d_in[i];
    a.out = (float*)d_out; a.ws = (unsigned char*)d_ws;
#if MK_SPLIT
    for (int ph = 0; ph < 26; ++ph) { a.ph_lo = ph; a.ph_hi = ph + 1; hipLaunchKernelGGL(mk_fwd, dim3(grid), dim3(512), LDS_TOTAL, stream, a); }
#else
    a.ph_lo = 0; a.ph_hi = 26;
    void* args[] = {&a};
    const hipError_t e = hipLaunchCooperativeKernel((const void*)mk_fwd, dim3(grid), dim3(512), args, LDS_TOTAL, stream);
    if (e != hipSuccess) fprintf(stderr, "kernel_launch: cooperative launch failed: %s (grid %d)\n", hipGetErrorString(e), grid);
#endif
}
```

```cpp
#include <hip/hip_runtime.h>
#include <hip/hip_cooperative_groups.h>
#include <cstdio>
#include <cstdint>
namespace cg = cooperative_groups;

#define LAS __attribute__((address_space(3)))
typedef unsigned short bf16_t;
typedef short bf16x8 __attribute__((ext_vector_type(8)));
typedef short s16x4 __attribute__((ext_vector_type(4)));
typedef float f32x4 __attribute__((ext_vector_type(4)));
typedef float f32x16 __attribute__((ext_vector_type(16)));
typedef unsigned u32x4 __attribute__((ext_vector_type(4)));
typedef unsigned u32x2 __attribute__((ext_vector_type(2)));

constexpr int LSEQ = 8208, LREAL = 8192, MP = 8448, DM = 2048;
constexpr int HF = 4104, MH = 4352;
constexpr int NIN = 11584, NPIN = 11776, NPA = 5376, NKR = 256, NPG = 6144;
constexpr int QL = 768, KVL = 512, NQ = 3072, NKV = 4096;
constexpr int DFF = 5632, NUP = 11264;
constexpr float EPS = 1e-6f;
constexpr int NMP = 7;

constexpr size_t al256(size_t x) { return (x + 255) & ~(size_t)255; }
constexpr size_t SZ_W0 = (size_t)NPIN * DM * 2;
constexpr size_t OW_UQ = 0, OW_UKV = OW_UQ + (size_t)NQ * QL * 2, OW_PA = OW_UKV + (size_t)NKV * KVL * 2, OW_PB = OW_PA + (size_t)DM * 1024 * 2,
                 OW_PC = OW_PB + (size_t)DM * DM * 2, OW_O = OW_PC + (size_t)DM * 1024 * 2, SZ_W1 = OW_O + (size_t)DM * DM * 2;
constexpr size_t O_W0 = 0;
constexpr size_t O_W1 = O_W0 + al256(SZ_W0);
constexpr size_t O_CH = O_W1 + al256(SZ_W1);
constexpr size_t O_SH = O_CH + al256((size_t)MH * MH * 2);
constexpr size_t O_CS = O_SH + al256((size_t)MH * MH * 2);
constexpr size_t O_ROPE = O_CS + al256((size_t)2 * 256 * 256 * 2);
constexpr size_t O_H = O_ROPE + al256((size_t)LSEQ * 64 * 4);
constexpr size_t O_X = O_H + al256((size_t)MP * DM * 4);
constexpr size_t O_PA = O_X + al256((size_t)MP * DM * 2);
constexpr size_t O_PG = O_PA + al256((size_t)MP * NPA * 2);
constexpr size_t O_KR = O_PG + al256((size_t)MP * NPG * 2);
constexpr size_t O_KV = O_KR + al256((size_t)MP * NKR * 2);
constexpr size_t O_KP = O_KV + al256((size_t)MP * NKV * 2);
constexpr size_t O_CC = O_KP + al256((size_t)MP * NQ * 2);
constexpr size_t O_EO = O_CC + al256((size_t)MP * 1024 * 2);
constexpr size_t O_MG = O_EO + al256((size_t)2 * MH * 1024 * 2);
constexpr size_t O_MB = O_MG + al256((size_t)MP * DM * 4);
constexpr size_t O_WD = O_MB + al256((size_t)MP * DM * 2);
constexpr size_t O_PM = O_WD + al256((size_t)DM * DFF * 2);
constexpr size_t PM_L = (size_t)16 * 16 * 16 * 128;
constexpr size_t O_CTL = O_PM + al256((PM_L + 16 * 16 * 16) * 4), CTL_BYTES = 16384;
constexpr size_t WS_END = O_CTL + CTL_BYTES;
constexpr size_t O_Q = O_PA, O_ET = O_Q + (size_t)MP * NQ * 2, O_UW = O_ET + (size_t)2 * 1024 * MH * 2;
static_assert(O_UW + (size_t)2 * MH * 1024 * 2 <= O_PG, "PA hosting");
static_assert((size_t)MP * NUP * 2 <= O_KR - O_PA, "u over pA|pG");
static_assert((size_t)MP * DFF * 2 <= O_CC - O_KV, "gated over kv|kp");
static_assert((size_t)DM * DFF * 2 <= SZ_W1 && (size_t)NUP * DM * 2 <= SZ_W0, "weight slots");

__device__ __forceinline__ unsigned cvt_pk_bf16(float lo, float hi) { unsigned r; asm volatile("v_cvt_pk_bf16_f32 %0, %1, %2" : "=v"(r) : "v"(lo), "v"(hi)); return r; }
__device__ __forceinline__ float bf_lo(unsigned w) { return __uint_as_float(w << 16); }
__device__ __forceinline__ float bf_hi(unsigned w) { return __uint_as_float(w & 0xffff0000u); }
__device__ __forceinline__ float bf1(bf16_t v) { return __uint_as_float(((unsigned)v) << 16); }
__device__ __forceinline__ bf16_t to_bf1(float f) { return (bf16_t)(cvt_pk_bf16(f, 0.f) & 0xffffu); }
__device__ __forceinline__ float shx(float v, int o, int lane) { return __int_as_float(__builtin_amdgcn_ds_bpermute((lane ^ o) << 2, __float_as_int(v))); }
__device__ __forceinline__ float wave_sum(float v, int lane) {
#pragma unroll
    for (int o = 1; o < 64; o <<= 1) v += shx(v, o, lane);
    return v;
}
__device__ __forceinline__ float sigm(float x) { return __builtin_amdgcn_rcpf(1.f + __builtin_amdgcn_exp2f(-1.4426950408889634f * x)); }
__device__ __forceinline__ int row_left(int r) { return r >= LSEQ ? -1 : (r == 0 ? LSEQ - 1 : (r == LREAL ? -1 : r - 1)); }
__device__ __forceinline__ int row_right(int r) { return r >= LSEQ ? -1 : (r == LREAL - 1 ? -1 : (r == LSEQ - 1 ? 0 : r + 1)); }
__device__ __forceinline__ int phys_of(int l) { return l >= 16 ? l - 16 : LREAL + l; }
__device__ __forceinline__ int pos_of(int r) { return r < LREAL ? r + 16 : r - LREAL; }
#define LDS_WAIT() asm volatile("s_waitcnt lgkmcnt(0)" ::: "memory")

namespace pg8 {
constexpr int BM = 256, BK = 64, HALF = 128, HTB = HALF * BK * 2, STAGE_BYTES = 8 * HTB, NXCD = 8, WGM = 8;
__device__ __forceinline__ int lds_byte(int r, int c) { const int st = (r >> 4) * 2 + (c >> 5), rr = r & 15, cc = c & 31, ob = rr * 64 + cc * 2; return st * 1024 + (ob ^ (((ob >> 9) & 1) << 5)); }
__device__ __forceinline__ void stage_rc(int b, int& R, int& C) { const int st = b / 1024, sb = b % 1024, swz = sb ^ (((sb >> 9) & 1) << 5); R = (st >> 1) * 16 + swz / 64; C = (st & 1) * 32 + (swz % 64) / 2; }
__device__ __forceinline__ int perm32(int rho) { const int n = rho >> 4, i = rho & 15; return 8 * (i >> 2) + 4 * n + (i & 3); }

struct Unit { int pm, pn, pb; };
enum { EPI_PIN = 0, EPI_BF16 = 1, EPI_MERGE0 = 2, EPI_MERGE1 = 3, EPI_MERGE2 = 4, EPI_RESID = 5, EPI_OUT = 6 };
struct Desc {
    const bf16_t* A; const bf16_t* Bt; int M, N, K, lda, ldb;
    int nb, nb2s; long sA1, sA2, sB1, sB2;
    int epi; void* o0; void* o1; void* o2; const bf16_t* gate; int ldc; long sO; float scale;
};
struct Order {
    int nM, nN, per, nwg, G, c;
    __device__ __forceinline__ void init(int M, int N, int nb, int G_, int c_) { nM = M / BM; nN = N / BM; per = nM * nN; nwg = per * nb; G = G_; c = c_; }
    __device__ __forceinline__ bool next(int i, Unit& u) const {
        const long L = (long)i * G + c; if (L >= nwg) return false;
        u.pb = (int)(L / per); int wgid = (int)(L % per);
        { const int q = per / NXCD, r = per % NXCD, xcd = wgid % NXCD, off = wgid / NXCD; wgid = (xcd < r ? xcd * (q + 1) : r * (q + 1) + (xcd - r) * q) + off; }
        const int nig = WGM * nN, gid = wgid / nig, fm = gid * WGM, gsz = (nM - fm) < WGM ? (nM - fm) : WGM;
        u.pm = fm + ((wgid % nig) % gsz); u.pn = (wgid % nig) / gsz; return true;
    }
};
__device__ __forceinline__ const char* unitA(const Desc& d, const Unit& u) {
    return (const char*)d.A + ((size_t)(u.pb >> d.nb2s) * d.sA1 + (size_t)(u.pb & ((1 << d.nb2s) - 1)) * d.sA2 + (size_t)u.pm * 256 * d.lda) * 2; }
__device__ __forceinline__ const char* unitB(const Desc& d, const Unit& u) {
    return (const char*)d.Bt + ((size_t)(u.pb >> d.nb2s) * d.sB1 + (size_t)(u.pb & ((1 << d.nb2s) - 1)) * d.sB2 + (size_t)u.pn * 256 * d.ldb) * 2; }

__device__ __forceinline__ f32x4 zero4() { float a, b, c, e; asm volatile("v_mov_b32 %0, 0\n\tv_mov_b32 %1, 0\n\tv_mov_b32 %2, 0\n\tv_mov_b32 %3, 0" : "=v"(a), "=v"(b), "=v"(c), "=v"(e)); return (f32x4){a, b, c, e}; }
__device__ __forceinline__ f32x4 sigm4(unsigned lo, unsigned hi) { f32x4 r; r[0] = sigm(bf_lo(lo)); r[1] = sigm(bf_hi(lo)); r[2] = sigm(bf_lo(hi)); r[3] = sigm(bf_hi(hi)); return r; }
__device__ __forceinline__ u32x4 pack8(f32x4 v0, f32x4 v1) { u32x4 w; w.x = cvt_pk_bf16(v0[0], v0[1]); w.y = cvt_pk_bf16(v0[2], v0[3]); w.z = cvt_pk_bf16(v1[0], v1[1]); w.w = cvt_pk_bf16(v1[2], v1[3]); return w; }

__device__ __forceinline__ void epi8(const Desc& d, int pb, int row, int col, f32x4 v0, f32x4 v1) {
    if (d.epi == EPI_PIN) {
        const int pn = col >> 8; bf16_t* p;
        if (pn < 21) p = (bf16_t*)d.o0 + (size_t)row * NPA + col;
        else if (pn == 21) p = (bf16_t*)d.o1 + (size_t)row * NKR + (col - 21 * 256);
        else p = (bf16_t*)d.o2 + (size_t)row * NPG + (col - 22 * 256);
        *(u32x4*)p = pack8(v0, v1);
    } else if (d.epi == EPI_BF16) {
        *(u32x4*)((bf16_t*)d.o0 + (size_t)pb * d.sO + (size_t)row * d.ldc + col) = pack8(v0 * d.scale, v1 * d.scale);
    } else if (d.epi == EPI_MERGE0 || d.epi == EPI_MERGE1 || d.epi == EPI_MERGE2) {
        const u32x4 gw = *(const u32x4*)(d.gate + (size_t)row * NPG + col);
        v0 *= sigm4(gw.x, gw.y); v1 *= sigm4(gw.z, gw.w);
        bf16_t* mp = (bf16_t*)d.o0 + (size_t)row * DM + col;
        if (d.epi != EPI_MERGE0) { const u32x4 m = *(const u32x4*)mp;
            v0 += (f32x4){bf_lo(m.x), bf_hi(m.x), bf_lo(m.y), bf_hi(m.y)}; v1 += (f32x4){bf_lo(m.z), bf_hi(m.z), bf_lo(m.w), bf_hi(m.w)}; }
        if (d.epi != EPI_MERGE2) *(u32x4*)mp = pack8(v0, v1);
        else *(u32x4*)((bf16_t*)d.o1 + (size_t)row * DM + col) = pack8(v0, v1);
    } else {
        float* hp = (float*)d.o0 + (size_t)row * DM + col;
        const float* rp = (row < LREAL ? (const float*)d.o2 + (size_t)row * DM : (const float*)d.gate + (size_t)(row - LREAL) * DM) + col;
        v0 += *(const f32x4*)rp; v1 += *(const f32x4*)(rp + 4);
        if (d.epi == EPI_RESID) { *(f32x4*)hp = v0; *(f32x4*)(hp + 4) = v1; }
        else if (row < LREAL) { float* op = (float*)d.o1 + (size_t)row * DM + col; *(f32x4*)op = v0; *(f32x4*)(op + 4) = v1; }
    }
}
__device__ __forceinline__ void epilogue(const Desc& d, const f32x4 (&acc)[2][2][4][2], const Unit& u, int wr, int wc, int fr, int fq) {
    const int row0 = u.pm * BM + wr * 64 + fr, col0 = u.pn * BM + wc * 32 + 8 * fq;
#pragma unroll
    for (int ai = 0; ai < 2; ++ai)
#pragma unroll
        for (int m = 0; m < 4; ++m) {
#pragma unroll
            for (int bj = 0; bj < 2; ++bj) epi8(d, u.pb, row0 + ai * HALF + m * 16, col0 + bj * HALF, acc[ai][bj][m][0], acc[ai][bj][m][1]);
            asm volatile("" ::: "memory"); }
}

__device__ __forceinline__ void skinny_phase(LAS unsigned char* lds, const Desc& g, int G, int bx, int wave, int lane) {
    asm volatile("" : "+v"(lane));
    const int fr = lane & 15, fq = lane >> 4, ks = g.K >> 3;
    const bf16_t* Ap = g.A + (size_t)(LREAL + fr) * g.lda + wave * ks + fq * 8;
    LAS f32x4* red = (LAS f32x4*)lds;
    if (bx >= 0)
    for (int grp = bx; grp < (g.N >> 5); grp += G) {
        const int c0 = grp * 32;
        const bf16_t* W0p = g.Bt + (size_t)(c0 + perm32(fr)) * g.ldb + wave * ks + fq * 8;
        const bf16_t* W1p = g.Bt + (size_t)(c0 + perm32(16 + fr)) * g.ldb + wave * ks + fq * 8;
        f32x4 a0 = zero4(), a1 = zero4();
#pragma unroll 8
        for (int kk = 0; kk < ks; kk += 32) {
            const bf16x8 af = *(const bf16x8*)(Ap + kk), w0 = *(const bf16x8*)(W0p + kk), w1 = *(const bf16x8*)(W1p + kk);
            a0 = __builtin_amdgcn_mfma_f32_16x16x32_bf16(w0, af, a0, 0, 0, 0);
            a1 = __builtin_amdgcn_mfma_f32_16x16x32_bf16(w1, af, a1, 0, 0, 0);
        }
        red[(wave * 64 + lane) * 2] = a0; red[(wave * 64 + lane) * 2 + 1] = a1;
        __syncthreads();
        if (wave == 0) {
#pragma unroll
            for (int w = 1; w < 8; ++w) { a0 += red[(w * 64 + lane) * 2]; a1 += red[(w * 64 + lane) * 2 + 1]; }
            epi8(g, 0, LREAL + fr, c0 + 8 * fq, a0, a1);
        }
        __syncthreads();
    }
}

__device__ __forceinline__ void gemm_phase(LAS unsigned char* lds, const Desc& g, int G, int cidx, int tid) {
    asm volatile("" : "+v"(tid));
    const int wid = __builtin_amdgcn_readfirstlane(tid >> 6), lane = tid & 63, wr = wid >> 2, wc = wid & 3, fr = lane & 15, fq = lane >> 4;
    Order S; S.init(g.M, g.N, g.nb, G, cidx);
    const int K = g.K, nt = K / BK;
    unsigned voffA[2], voffB[2];
#pragma unroll
    for (int i = 0; i < 2; ++i) { int R, C; stage_rc(tid * 16 + i * 8192, R, C); const int Rb = (R & ~31) + perm32(R & 31);
        voffA[i] = (unsigned)(R * g.lda + C) * 2u; voffB[i] = (unsigned)(Rb * g.ldb + C) * 2u; }
    const size_t kstep = (size_t)(BK * 2);
    const size_t hstepA = (size_t)HALF * g.lda * 2, hstepB = (size_t)HALF * g.ldb * 2;
    const unsigned ldsw = (unsigned)wid * 1024u;
    const int aoff = lds_byte(wr * 64 + fr, fq * 8), boff = lds_byte(wc * 32 + fr, fq * 8);
#define PG8_SA(b, h) (((b) * 2 + (h)) * HTB)
#define PG8_SB(b, h) ((4 + (b) * 2 + (h)) * HTB)
#define PG8_STAGE(bufoff, gbase, voff) do { _Pragma("unroll") for (int _i = 0; _i < 2; ++_i) \
        __builtin_amdgcn_global_load_lds((const unsigned*)((const char*)(gbase) + (voff)[_i]), (LAS unsigned*)(lds + (bufoff) + ldsw + _i * 8192), 16, 0, 0); } while (0)
#define PG8_LDA(dst, b, h) do { _Pragma("unroll") for (int m = 0; m < 4; ++m) _Pragma("unroll") for (int k = 0; k < 2; ++k) dst[m][k] = *(const LAS bf16x8*)(lds + PG8_SA(b, h) + aoff + m * 2048 + k * 1024); } while (0)
#define PG8_LDB(dst, b, h) do { _Pragma("unroll") for (int n = 0; n < 2; ++n) _Pragma("unroll") for (int k = 0; k < 2; ++k) dst[n][k] = *(const LAS bf16x8*)(lds + PG8_SB(b, h) + boff + n * 2048 + k * 1024); } while (0)
#define PG8_MMA(ai, bj, At, Bt) do { __builtin_amdgcn_s_setprio(1); _Pragma("unroll") for (int m = 0; m < 4; ++m) _Pragma("unroll") for (int n = 0; n < 2; ++n) _Pragma("unroll") for (int k = 0; k < 2; ++k) \
        acc[ai][bj][m][n] = __builtin_amdgcn_mfma_f32_16x16x32_bf16(Bt[n][k], At[m][k], acc[ai][bj][m][n], 0, 0, 0); __builtin_amdgcn_s_setprio(0); } while (0)
#define PG8_WAIT_V(n) asm volatile("s_waitcnt vmcnt(" #n ")" ::: "memory")
#define PG8_WAIT_L(n) asm volatile("s_waitcnt lgkmcnt(" #n ")" ::: "memory")
#define PG8_BAR __builtin_amdgcn_s_barrier()
#define PG8_SCHED __builtin_amdgcn_sched_barrier(0)
    Unit cur, nxt; int ui = 0;
    if (!S.next(0, cur)) return;
    f32x4 acc[2][2][4][2];
#pragma unroll
    for (int a = 0; a < 2; ++a)
#pragma unroll
        for (int b = 0; b < 2; ++b)
#pragma unroll
            for (int m = 0; m < 4; ++m)
#pragma unroll
                for (int n = 0; n < 2; ++n) acc[a][b][m][n] = zero4();
    bf16x8 At[4][2], B0[2][2], B1[2][2];
    const char* cA = unitA(g, cur); const char* cB = unitB(g, cur);
    PG8_STAGE(PG8_SB(0, 0), cB, voffB); PG8_STAGE(PG8_SB(0, 1), cB + hstepB, voffB); PG8_STAGE(PG8_SA(0, 0), cA, voffA); PG8_STAGE(PG8_SA(0, 1), cA + hstepA, voffA);
    if (wr == 1) PG8_BAR;
    PG8_WAIT_V(2); PG8_BAR;
    PG8_STAGE(PG8_SB(1, 0), cB + kstep, voffB); PG8_STAGE(PG8_SA(1, 0), cA + kstep, voffA); PG8_STAGE(PG8_SB(1, 1), cB + hstepB + kstep, voffB);
    PG8_WAIT_V(6); PG8_BAR;
    for (;;) {
        const bool has_next = S.next(ui + 1, nxt);
        const char* nA = has_next ? unitA(g, nxt) : cA; const char* nB = has_next ? unitB(g, nxt) : cB;
        for (int t = 0; t < nt; t += 2) {
            const bool last = (t == nt - 2);
            const char* a1 = cA + (size_t)(t + 1) * kstep;
            const char* a2 = last ? nA : cA + (size_t)(t + 2) * kstep; const char* b2 = last ? nB : cB + (size_t)(t + 2) * kstep;
            const char* a3 = a2 + kstep; const char* b3 = b2 + kstep;
            PG8_LDB(B0, 0, 0); PG8_LDB(B1, 0, 1); PG8_SCHED; PG8_LDA(At, 0, 0); PG8_STAGE(PG8_SA(1, 1), a1 + hstepA, voffA);
            PG8_WAIT_V(8); PG8_WAIT_L(0); PG8_BAR; PG8_MMA(0, 0, At, B0); PG8_MMA(0, 1, At, B1); PG8_BAR; PG8_SCHED;
            PG8_LDA(At, 0, 1); PG8_STAGE(PG8_SB(0, 0), b2, voffB); PG8_STAGE(PG8_SB(0, 1), b2 + hstepB, voffB); PG8_STAGE(PG8_SA(0, 0), a2, voffA);
            PG8_WAIT_V(8); PG8_WAIT_L(0); PG8_BAR; PG8_MMA(1, 0, At, B0); PG8_MMA(1, 1, At, B1); PG8_BAR; PG8_SCHED;
            PG8_LDB(B0, 1, 0); PG8_LDB(B1, 1, 1); PG8_SCHED; PG8_LDA(At, 1, 0); PG8_STAGE(PG8_SA(0, 1), a2 + hstepA, voffA);
            PG8_WAIT_V(8); PG8_WAIT_L(0); PG8_BAR; PG8_MMA(0, 0, At, B0); PG8_MMA(0, 1, At, B1); PG8_BAR; PG8_SCHED;
            PG8_LDA(At, 1, 1); PG8_STAGE(PG8_SB(1, 0), b3, voffB); PG8_STAGE(PG8_SB(1, 1), b3 + hstepB, voffB); PG8_STAGE(PG8_SA(1, 0), a3, voffA);
            PG8_WAIT_V(8); PG8_WAIT_L(0); PG8_BAR; PG8_MMA(1, 0, At, B0); PG8_MMA(1, 1, At, B1); PG8_BAR; PG8_SCHED;
        }
        if (wr == 0) PG8_BAR;
        epilogue(g, acc, cur, wr, wc, fr, fq);
        if (!has_next) break;
#pragma unroll
        for (int a = 0; a < 2; ++a)
#pragma unroll
            for (int b = 0; b < 2; ++b)
#pragma unroll
                for (int m = 0; m < 4; ++m)
#pragma unroll
                    for (int n = 0; n < 2; ++n) acc[a][b][m][n] = zero4();
        cur = nxt; cA = nA; cB = nB; ++ui;
        if (wr == 1) PG8_BAR;
    }
    PG8_WAIT_V(0);
    PG8_BAR;
#undef PG8_SA
#undef PG8_SB
#undef PG8_STAGE
#undef PG8_LDA
#undef PG8_LDB
#undef PG8_MMA
#undef PG8_WAIT_V
#undef PG8_WAIT_L
#undef PG8_BAR
#undef PG8_SCHED
}
}

namespace att {
constexpr int KVBLK = 64, NW = 8, LDQ = NQ, LDKK = NQ, LDV = NKV, LDO = DM;
constexpr int SHM_V = 64 * 128 * 2, SHM_K = 64 * 192 * 2;
constexpr int QREG = 8;
constexpr int LDS_V = 0, LDS_K = 2 * SHM_V, LDS_WS = LDS_K + 2 * SHM_K, LDS_QT = LDS_WS + NW * 64 * 4, LDS_BYTES = LDS_QT + NW * (12 - QREG) * 1024;
constexpr int NT = (LSEQ + KVBLK - 1) / KVBLK;
static_assert(NT % 2 == 1 && LSEQ - (NT - 1) * KVBLK == 16, "tail mask assumes 16 valid keys in an odd last tile");
#define KSWZ(row, colB) ((row) * 384 + ((colB) ^ ((((row) >> 1) & 7) << 4)))
#define SBAR() __builtin_amdgcn_sched_barrier(0)
__device__ __forceinline__ int crow(int r, int hi) { return (r & 3) + 8 * (r >> 2) + 4 * hi; }
__device__ __forceinline__ int v_st(int k, int c) { const int kk = (k & ~0xC) | ((k & 4) << 1) | ((k & 8) >> 1); return ((kk >> 3) * 4 + (c >> 5)) * 512 + ((kk & 7) * 32 + (c & 31)) * 2; }
__device__ __forceinline__ int v_rd_base(int lane) { return ((lane & 3) << 3) | (((lane >> 2) & 3) << 6) | (((lane >> 4) & 1) << 5) | (((lane >> 5) & 1) << 8); }
constexpr int v_rd_off(int d0, int ks, int half) { return d0 * 512 + ks * 4096 + half * 2048; }
template <int OFF> __device__ __forceinline__ s16x4 tr_read(int vb) {
    s16x4 r; asm volatile("ds_read_b64_tr_b16 %0, %1 offset:%2" : "=&v"(r) : "v"(vb), "i"(OFF) : "memory"); return r;
}
struct VBlk { s16x4 l0, h0, l1, h1, l2, h2, l3, h3; };
template <int D0> __device__ __forceinline__ void pv_load(VBlk& b, int vb) {
    b.l0 = tr_read<v_rd_off(D0, 0, 0)>(vb); b.h0 = tr_read<v_rd_off(D0, 0, 1)>(vb); b.l1 = tr_read<v_rd_off(D0, 1, 0)>(vb); b.h1 = tr_read<v_rd_off(D0, 1, 1)>(vb);
    b.l2 = tr_read<v_rd_off(D0, 2, 0)>(vb); b.h2 = tr_read<v_rd_off(D0, 2, 1)>(vb); b.l3 = tr_read<v_rd_off(D0, 3, 0)>(vb); b.h3 = tr_read<v_rd_off(D0, 3, 1)>(vb);
}
__device__ __forceinline__ void pv_mma(f32x16& od, const VBlk& b, bf16x8 pa0, bf16x8 pa1, bf16x8 pa2, bf16x8 pa3) {
#define PK(L, H) (bf16x8){L[0], L[1], L[2], L[3], H[0], H[1], H[2], H[3]}
    od = __builtin_amdgcn_mfma_f32_32x32x16_bf16(pa0, PK(b.l0, b.h0), od, 0, 0, 0);
    od = __builtin_amdgcn_mfma_f32_32x32x16_bf16(pa1, PK(b.l1, b.h1), od, 0, 0, 0);
    od = __builtin_amdgcn_mfma_f32_32x32x16_bf16(pa2, PK(b.l2, b.h2), od, 0, 0, 0);
    od = __builtin_amdgcn_mfma_f32_32x32x16_bf16(pa3, PK(b.l3, b.h3), od, 0, 0, 0);
#undef PK
}
__device__ __forceinline__ void pv_d0(f32x16* o, int vb, bf16x8 pa0, bf16x8 pa1, bf16x8 pa2, bf16x8 pa3) {
    VBlk A, B;
    pv_load<0>(A, vb); pv_load<1>(B, vb);
    asm volatile("s_waitcnt lgkmcnt(8)" ::: "memory"); SBAR(); pv_mma(o[0], A, pa0, pa1, pa2, pa3); SBAR();
    pv_load<2>(A, vb);
    asm volatile("s_waitcnt lgkmcnt(8)" ::: "memory"); SBAR(); pv_mma(o[1], B, pa0, pa1, pa2, pa3); SBAR();
    pv_load<3>(B, vb);
    asm volatile("s_waitcnt lgkmcnt(8)" ::: "memory"); SBAR(); pv_mma(o[2], A, pa0, pa1, pa2, pa3); SBAR();
    asm volatile("s_waitcnt lgkmcnt(0)" ::: "memory"); SBAR(); pv_mma(o[3], B, pa0, pa1, pa2, pa3); SBAR();
}
__device__ __forceinline__ void qkt(f32x16& p0, f32x16& p1, LAS const unsigned char* Ks, const bf16x8* qr, LAS const unsigned char* qt, int r32, int hi) {
    p0 = (f32x16){}; p1 = (f32x16){};
#pragma unroll
    for (int d0 = 0; d0 < 12; ++d0) { const int cb = (d0 * 16 + hi * 8) * 2;
        const bf16x8 b0 = *(const LAS bf16x8*)(Ks + KSWZ(r32, cb));
        const bf16x8 b1 = *(const LAS bf16x8*)(Ks + KSWZ(32 + r32, cb));
        const bf16x8 qf = d0 < QREG ? qr[d0 < QREG ? d0 : 0] : *(const LAS bf16x8*)(qt + (d0 - QREG) * 1024);
        p0 = __builtin_amdgcn_mfma_f32_32x32x16_bf16(b0, qf, p0, 0, 0, 0);
        p1 = __builtin_amdgcn_mfma_f32_32x32x16_bf16(b1, qf, p1, 0, 0, 0);
        if ((d0 & 3) == 3) SBAR(); }
}
__device__ __forceinline__ void expP(f32x16& p0, f32x16& p1, float MB) {
#pragma unroll
    for (int r = 0; r < 16; ++r) p0[r] = __builtin_amdgcn_exp2f(p0[r] - MB);
#pragma unroll
    for (int r = 0; r < 16; ++r) p1[r] = __builtin_amdgcn_exp2f(p1[r] - MB);
}
__device__ __forceinline__ void maskLast(f32x16& p0, f32x16& p1) {
#pragma unroll
    for (int r = 8; r < 16; ++r) p0[r] = 0.f;
#pragma unroll
    for (int r = 0; r < 16; ++r) p1[r] = 0.f;
}
__device__ __forceinline__ void finishP(const f32x16& p0, const f32x16& p1, float& l_reg, bf16x8& pa0, bf16x8& pa1, bf16x8& pa2, bf16x8& pa3) {
    float ps = 0.f;
#pragma unroll
    for (int r = 0; r < 16; ++r) ps += p0[r];
#pragma unroll
    for (int r = 0; r < 16; ++r) ps += p1[r];
    l_reg += ps;
#define PK4(P, BASE, OUT) do { unsigned a0 = cvt_pk_bf16(P[BASE + 0], P[BASE + 1]), a1 = cvt_pk_bf16(P[BASE + 2], P[BASE + 3]);   \
    unsigned b0 = cvt_pk_bf16(P[BASE + 4], P[BASE + 5]), b1 = cvt_pk_bf16(P[BASE + 6], P[BASE + 7]);                              \
    auto r0 = __builtin_amdgcn_permlane32_swap(a0, b0, false, false); auto r1 = __builtin_amdgcn_permlane32_swap(a1, b1, false, false); \
    u32x4 w = {r0[0], r1[0], r0[1], r1[1]}; OUT = *reinterpret_cast<bf16x8*>(&w); } while (0)
    PK4(p0, 0, pa0); PK4(p0, 8, pa1); PK4(p1, 0, pa2); PK4(p1, 8, pa3);
#undef PK4
}

__device__ __forceinline__ void attn_unit(const bf16_t* __restrict__ Qb, const bf16_t* __restrict__ Kh, const bf16_t* __restrict__ Vh, bf16_t* __restrict__ Ob,
                                          LAS unsigned char* lds, float MB, int tid, int nrows, int t0, int t1, float* part, float* partl) {
    const int wid = __builtin_amdgcn_readfirstlane(tid >> 6), lane = tid & 63, r32 = lane & 31, hi = lane >> 5;
    LAS unsigned char* V_lds = lds + LDS_V; LAS unsigned char* K_lds = lds + LDS_K;
    LAS float* li_l = (LAS float*)(lds + LDS_WS) + wid * 64;
    const bool act = wid * 32 < nrows;
    float l_reg = 0.f; f32x16 o[4] = {}; bf16x8 qr[QREG];
    LAS unsigned char* qt = lds + LDS_QT + wid * ((12 - QREG) * 1024) + lane * 16;
    const unsigned qo = (unsigned)((wid * 32 + r32) * LDQ + hi * 8) * 2u;
#pragma unroll
    for (int d0 = 0; d0 < QREG; ++d0) qr[d0] = *(const bf16x8*)((const char*)Qb + qo + d0 * 32);
#pragma unroll
    for (int d0 = QREG; d0 < 12; ++d0) *(LAS bf16x8*)(qt + (d0 - QREG) * 1024) = *(const bf16x8*)((const char*)Qb + qo + d0 * 32);
    unsigned ko[3], vo[2];
#pragma unroll
    for (int i = 0; i < 3; ++i) { const int sl = tid + 512 * i, row = sl / 24, pc = sl - row * 24, ch = pc ^ ((row >> 1) & 7); ko[i] = (unsigned)(row * LDKK + ch * 8) * 2u; }
#pragma unroll
    for (int i = 0; i < 2; ++i) { const int sl = tid + 512 * i, sub = sl >> 5, kk = (sub >> 2) * 8 + ((sl >> 2) & 7), c = (sub & 3) * 32 + (sl & 3) * 8;
        const int kx = (kk & ~0xC) | ((kk & 4) << 1) | ((kk & 8) >> 1); vo[i] = (unsigned)(kx * LDV + c) * 2u; }
    const int vb0 = (int)(unsigned)(uintptr_t)V_lds + v_rd_base(lane);
    const unsigned ldw = (unsigned)wid * 1024u;
#define SDMA(k0, b) do { const char* _vp = (const char*)Vh + (size_t)(k0) * (LDV * 2); const char* _kp = (const char*)Kh + (size_t)(k0) * (LDKK * 2); \
    _Pragma("unroll") for (int _i = 0; _i < 3; ++_i) __builtin_amdgcn_global_load_lds((const unsigned*)(_kp + ko[_i]), (LAS unsigned*)(K_lds + (b) * SHM_K + _i * 8192 + ldw), 16, 0, 0); \
    _Pragma("unroll") for (int _i = 0; _i < 2; ++_i) __builtin_amdgcn_global_load_lds((const unsigned*)(_vp + vo[_i]), (LAS unsigned*)(V_lds + (b) * SHM_V + _i * 8192 + ldw), 16, 0, 0); } while (0)
    f32x16 p0, p1; bf16x8 pa0, pa1, pa2, pa3;
    SDMA(t0 * KVBLK, 0); asm volatile("s_waitcnt vmcnt(0)" ::: "memory"); __syncthreads();
    for (int j = t0; j < t1; ++j) {
        const int b = (j - t0) & 1; const bool more = (j + 1 < t1);
        if (more) { if (b) SDMA((j + 1) * KVBLK, 0); else SDMA((j + 1) * KVBLK, 1); }
        if (act) {
        SBAR(); qkt(p0, p1, K_lds + b * SHM_K, qr, qt, r32, hi);
        expP(p0, p1, MB);
        if (j == NT - 1) maskLast(p0, p1);
        finishP(p0, p1, l_reg, pa0, pa1, pa2, pa3); SBAR();
        pv_d0(o, vb0 + b * SHM_V, pa0, pa1, pa2, pa3);
        }
        asm volatile("s_waitcnt vmcnt(0)" ::: "memory");
        __syncthreads();
    }
    if (act && part) {
        l_reg += shx(l_reg, 32, lane);
        if (hi == 0 && r32 < 16) partl[r32] = l_reg;
#pragma unroll
        for (int r = 0; r < 8; ++r) {
#pragma unroll
            for (int d0 = 0; d0 < 4; ++d0) part[crow(r, hi) * 128 + d0 * 32 + r32] = o[d0][r]; }
    } else if (act) {
    l_reg += shx(l_reg, 32, lane);
    if (hi == 0) li_l[r32] = l_reg;
    asm volatile("s_waitcnt lgkmcnt(0)" ::: "memory");
    float rli[16];
#pragma unroll
    for (int r = 0; r < 16; ++r) rli[r] = __builtin_amdgcn_rcpf(li_l[crow(r, hi)]);
    int r32e = r32; asm volatile("" : "+v"(r32e));
    const unsigned ob = (unsigned)((wid * 32) * LDO + r32e) * 2u;
#pragma unroll
    for (int r = 0; r < 16; ++r) { const int orow = crow(r, hi);
        if (wid * 32 + orow < nrows) {
#pragma unroll
        for (int d0 = 0; d0 < 4; ++d0) *(bf16_t*)((char*)Ob + ob + (unsigned)(orow * LDO + d0 * 32) * 2u) = to_bf1(o[d0][r] * rli[r]); } }
    }
    __syncthreads();
#undef SDMA
}
}


#define XB_TMO      128
#define XB_XCNT(j)  (256  + 64 * (j))
#define XB_XSUB(j)  (1280 + 64 * (j))
#define XB_XGEN(j)  (2304 + 64 * (j))
#define XB_TOP      3328
#define XB_TOPGEN   3392
#define XCD_BAR_WORDS 3456
#define XB_SPIN_CAP (1u << 22)
static_assert(XCD_BAR_WORDS * 4 <= CTL_BYTES, "barrier words");
__device__ __forceinline__ unsigned xb_ld(unsigned* p)              { return __hip_atomic_load(p, __ATOMIC_RELAXED, __HIP_MEMORY_SCOPE_AGENT); }
__device__ __forceinline__ unsigned xb_add(unsigned* p, unsigned v) { return __hip_atomic_fetch_add(p, v, __ATOMIC_RELAXED, __HIP_MEMORY_SCOPE_AGENT); }
__device__ __forceinline__ unsigned xb_xcc_id() { return (unsigned)__builtin_amdgcn_s_getreg((3 << 11) | 20) & 0xFu; }
#define XB_SPIN(cond, bar) do { unsigned _sp = 0; while (cond) { __builtin_amdgcn_s_sleep(1); \
    if ((++_sp & 255u) == 0u) { if (xb_ld(&(bar)[XB_TMO])) break; if (_sp > XB_SPIN_CAP) { atomicAdd(&(bar)[XB_TMO], 1u); break; } } } } while (0)
struct XcdBarrier { unsigned* bar; unsigned x; volatile LAS unsigned* st; };
__device__ __forceinline__ void xcd_barrier_complete(unsigned* bar, unsigned x, unsigned& nloc, unsigned& nx) {
    const unsigned G = gridDim.x * gridDim.y * gridDim.z;
    unsigned sum, cnt, mine, sp = 0u;
    for (;;) {
        sum = 0u; cnt = 0u; mine = 0u;
#pragma unroll
        for (unsigned j = 0; j < 16; ++j) { const unsigned c = xb_ld(&bar[XB_XCNT(j)]); sum += c; cnt += (c > 0u) ? 1u : 0u; mine = (j == x) ? c : mine; }
        if (sum == G) break;
        __builtin_amdgcn_s_sleep(1);
        if ((++sp & 255u) == 0u) { if (xb_ld(&bar[XB_TMO])) break; if (sp > XB_SPIN_CAP) { atomicAdd(&bar[XB_TMO], 1u); break; } }
    }
    nloc = mine > 0u ? mine : 1u; nx = cnt > 0u ? cnt : 1u;
}
__device__ __forceinline__ void xcd_barrier(const XcdBarrier& b, int tid) {
    asm volatile("s_waitcnt vmcnt(0)" ::: "memory");
    __syncthreads();
    if (tid == 0) {
        unsigned* bar = b.bar;
        __builtin_amdgcn_s_waitcnt(0);
        unsigned nloc = b.st[0], nx = b.st[1];
        if (nloc == 0u) { xcd_barrier_complete(bar, b.x, nloc, nx); b.st[0] = nloc; b.st[1] = nx; }
        const unsigned old = xb_add(&bar[XB_XSUB(b.x)], 1u);
        const unsigned gen = old / nloc;
        if (old + 1u == (gen + 1u) * nloc) {
            __builtin_amdgcn_fence(__ATOMIC_RELEASE, "agent");
            asm volatile("s_waitcnt vmcnt(0)" ::: "memory");
            const unsigned og = xb_add(&bar[XB_TOP], 1u);
            const unsigned tg = og / nx;
            if (og + 1u == (tg + 1u) * nx) xb_add(&bar[XB_TOPGEN], 1u);
            else XB_SPIN(xb_ld(&bar[XB_TOPGEN]) == tg, bar);
            __builtin_amdgcn_fence(__ATOMIC_ACQUIRE, "agent");
            xb_add(&bar[XB_XGEN(b.x)], 1u);
            asm volatile("s_waitcnt vmcnt(0)" ::: "memory");
        } else {
            XB_SPIN(xb_ld(&bar[XB_XGEN(b.x)]) == gen, bar);
            __builtin_amdgcn_fence(__ATOMIC_ACQUIRE, "agent");
            asm volatile("s_waitcnt vmcnt(0)" ::: "memory");
        }
    }
    __syncthreads();
}

#ifndef REP_MASK
#define REP_MASK 0
#endif
#ifndef ATT_REPEAT
#define ATT_REPEAT 1
#endif
constexpr int LDS_TOTAL = 147456;
static_assert(pg8::STAGE_BYTES <= LDS_TOTAL && att::LDS_BYTES <= LDS_TOTAL, "LDS");
struct Args { const float* in[19]; float* out; unsigned char* ws; int ph_lo, ph_hi; };
enum { I_X = 0, I_META, I_GMIX, I_WIN, I_GQA, I_GKVA, I_WUQ, I_WUKV, I_GQ, I_GK, I_CONVC, I_WPA, I_WPB, I_WPC, I_WO, I_GFFN, I_WUP, I_CONVF, I_WDOWN };

__device__ __forceinline__ void tr_item(const float* __restrict__ W, int K, int N, bf16_t* __restrict__ WT, int dst_row0, int src_col0, int k0, LAS float* scr, int lane) {
    if (src_col0 >= 0) {
        const float* wp = W + (size_t)(k0 + (lane >> 5)) * N + src_col0 + (lane & 31);
        float t[32];
#pragma unroll
        for (int i = 0; i < 32; ++i) t[i] = __builtin_nontemporal_load(wp + (size_t)(2 * i) * N);
#pragma unroll
        for (int i = 0; i < 32; ++i) scr[(2 * i + (lane >> 5)) * 33 + (lane & 31)] = t[i];
    } else {
#pragma unroll 8
        for (int i = 0; i < 32; ++i) { const int kk = 2 * i + (lane >> 5); scr[kk * 33 + (lane & 31)] = 0.f; }
    }
    LDS_WAIT(); asm volatile("" ::: "memory");
    const int c = lane & 7;
#pragma unroll
    for (int j = 0; j < 4; ++j) { const int n = (lane >> 3) + 8 * j; const LAS float* s = scr + (8 * c) * 33 + n;
        u32x4 o; o.x = cvt_pk_bf16(s[0 * 33], s[1 * 33]); o.y = cvt_pk_bf16(s[2 * 33], s[3 * 33]); o.z = cvt_pk_bf16(s[4 * 33], s[5 * 33]); o.w = cvt_pk_bf16(s[6 * 33], s[7 * 33]);
        *(u32x4*)(WT + (size_t)(dst_row0 + n) * K + k0 + 8 * c) = o; }
    LDS_WAIT(); asm volatile("" ::: "memory");
}
__device__ __forceinline__ bool conv_plain(int& it, const float* W, int K, int N, bf16_t* WT, LAS float* scr, int lane) {
    const int nblk = N / 32, items = (K / 64) * nblk;
    if (it < items) { const int kb = it / nblk, nb = it - kb * nblk; tr_item(W, K, N, WT, nb * 32, nb * 32, kb * 64, scr, lane); return true; }
    it -= items; return false;
}

__device__ __forceinline__ unsigned convpair(unsigned b, unsigned c0, unsigned h0, unsigned c1, unsigned h1, unsigned c2, unsigned h2,
                                             float w0a, float w0b, float w1a, float w1b, float w2a, float w2b) {
    const float ya = bf_lo(b) * (w0a * bf_lo(c0) * bf_lo(h0) + w1a * bf_lo(c1) * bf_lo(h1) + w2a * bf_lo(c2) * bf_lo(h2));
    const float yb = bf_hi(b) * (w0b * bf_hi(c0) * bf_hi(h0) + w1b * bf_hi(c1) * bf_hi(h1) + w2b * bf_hi(c2) * bf_hi(h2));
    return cvt_pk_bf16(ya, yb);
}
__device__ __forceinline__ unsigned addpair(unsigned x, unsigned y, float sg) { return cvt_pk_bf16(bf_lo(x) + sg * bf_lo(y), bf_hi(x) + sg * bf_hi(y)); }
__global__ void __launch_bounds__(512, 2) mk_fwd(Args a) {
    extern __shared__ __attribute__((aligned(16))) unsigned char lds_raw[];
    LAS unsigned char* lds = (LAS unsigned char*)lds_raw;
    cg::grid_group grid = cg::this_grid();
    const int wave_s = __builtin_amdgcn_readfirstlane((int)threadIdx.x >> 6);
    volatile LAS unsigned* xst = (volatile LAS unsigned*)(lds + LDS_TOTAL - 64);
    if (threadIdx.x < 2) xst[threadIdx.x] = 0u;
    __syncthreads();
    XcdBarrier xbar; xbar.bar = (unsigned*)(a.ws + O_CTL); xbar.x = xb_xcc_id(); xbar.st = xst;
    if (threadIdx.x == 0) (void)xb_add(&xbar.bar[XB_XCNT(xbar.x)], 1u);
    for (int ph = a.ph_lo; ph < a.ph_hi; ++ph) {
        if (ph > a.ph_lo) { if (ph == a.ph_lo + 1) grid.sync(); else xcd_barrier(xbar, (int)threadIdx.x); }
        for (int rep = 0; rep <= ((REP_MASK >> (ph % 13)) & 1); ++rep) {
        int lane; asm volatile("v_mbcnt_lo_u32_b32 %0, -1, 0\n\tv_mbcnt_hi_u32_b32 %0, -1, %0" : "=v"(lane));
        unsigned char* ws = a.ws; asm volatile("" : "+s"(ws));
        const int wave = wave_s, tid = wave * 64 + lane;
        const int G = gridDim.x, bx = blockIdx.x, gw = bx * 8 + wave, NGW = G * 8;
        bf16_t* W0 = (bf16_t*)(ws + O_W0); unsigned char* W1 = ws + O_W1;
        bf16_t* CH = (bf16_t*)(ws + O_CH); bf16_t* SH = (bf16_t*)(ws + O_SH); bf16_t* CS = (bf16_t*)(ws + O_CS); float* ROPE = (float*)(ws + O_ROPE);
        float* H = (float*)(ws + O_H); bf16_t* X = (bf16_t*)(ws + O_X); bf16_t* PA = (bf16_t*)(ws + O_PA); bf16_t* PG = (bf16_t*)(ws + O_PG);
        bf16_t* KR = (bf16_t*)(ws + O_KR); bf16_t* KV = (bf16_t*)(ws + O_KV); bf16_t* KP = (bf16_t*)(ws + O_KP); bf16_t* CC = (bf16_t*)(ws + O_CC);
        bf16_t* EO = (bf16_t*)(ws + O_EO); float* MG = (float*)(ws + O_MG); bf16_t* MB = (bf16_t*)(ws + O_MB);
        bf16_t* Q = (bf16_t*)(ws + O_Q); bf16_t* ET = (bf16_t*)(ws + O_ET); bf16_t* UW = (bf16_t*)(ws + O_UW);
        bf16_t* CQN = X; bf16_t* CKVN = X + (size_t)MP * QL; bf16_t* AO = X; bf16_t* U = PA; bf16_t* GT = KV;
        LAS float* scr = (LAS float*)(lds + wave * 16384);

        const int l = ph / 13, k = ph - l * 13;
        if (k == 0) {
            if (l == 0) {
                const int gt = bx * 512 + tid, NTH = G * 512;
                { const f32x4 zf = pg8::zero4(); const u32x4 z4 = {__float_as_uint(zf[0]), __float_as_uint(zf[1]), __float_as_uint(zf[2]), __float_as_uint(zf[3])};
                for (int idx = gt; idx < 48 * (NKV / 8); idx += NTH) *(u32x4*)(KV + (size_t)LSEQ * NKV + (size_t)idx * 8) = z4;
                for (int idx = gt; idx < 48 * (NQ / 8); idx += NTH) *(u32x4*)(KP + (size_t)LSEQ * NQ + (size_t)idx * 8) = z4; }
                for (int idx = gt; idx < LSEQ * 32; idx += NTH) { const int pos = idx >> 5, i = idx & 31;
                    const float inv = __builtin_amdgcn_exp2f(-(float)i * (13.287712379549449f / 32.f)); const float ang = (float)pos * inv;
                    double rv = (double)ang * 0.15915494309189535; rv -= __builtin_floor(rv); const float rf = (float)rv;
                    ROPE[pos * 64 + i] = __builtin_amdgcn_cosf(rf); ROPE[pos * 64 + 32 + i] = __builtin_amdgcn_sinf(rf); }
                for (int idx = gt; idx < 2 * 65536; idx += NTH) { const int cs = idx >> 16, m = (idx >> 8) & 255, c = idx & 255; const float rf = (float)((m * c) & 255) * (1.f / 256.f);
                    CS[idx] = to_bf1(cs ? __builtin_amdgcn_sinf(rf) : __builtin_amdgcn_cosf(rf)); }
                for (int idx = gt; idx < MH * (MH / 8); idx += NTH) { const int kf = idx / (MH / 8), lf0 = (idx - kf * (MH / 8)) * 8;
                    int t = (int)(((long)kf * lf0) % LSEQ); float cv[8], sv[8];
#pragma unroll
                    for (int j = 0; j < 8; ++j) { const bool ok = (kf <= HF) && (lf0 + j <= HF); const float rf = (float)t * (1.f / (float)LSEQ);
                        cv[j] = ok ? __builtin_amdgcn_cosf(rf) : 0.f; sv[j] = ok ? __builtin_amdgcn_sinf(rf) : 0.f; t += kf; if (t >= LSEQ) t -= LSEQ; }
                    u32x4 wc_, ws_; wc_.x = cvt_pk_bf16(cv[0], cv[1]); wc_.y = cvt_pk_bf16(cv[2], cv[3]); wc_.z = cvt_pk_bf16(cv[4], cv[5]); wc_.w = cvt_pk_bf16(cv[6], cv[7]);
                    ws_.x = cvt_pk_bf16(sv[0], sv[1]); ws_.y = cvt_pk_bf16(sv[2], sv[3]); ws_.z = cvt_pk_bf16(sv[4], sv[5]); ws_.w = cvt_pk_bf16(sv[6], sv[7]);
                    *(u32x4*)(CH + (size_t)kf * MH + lf0) = wc_; *(u32x4*)(SH + (size_t)kf * MH + lf0) = ws_; }
            }
            {
                const float* win = a.in[I_WIN] + (size_t)l * DM * NIN;
                const int nblk_in = NPIN / 32, items_in = (DM / 64) * nblk_in;
                const int items_small = (QL / 64) * (NQ / 32) + (KVL / 64) * (NKV / 32) + (1024 / 64) * (DM / 32) * 2 + (DM / 64) * (DM / 32) * 2;
                for (int it0 = gw; it0 < items_in + items_small; it0 += NGW) {
                    int it = it0;
                    if (it < items_in) { const int kb = it / nblk_in, nb = it - kb * nblk_in; const int j = nb * 32; int src;
                        if (j < 2304) src = j; else if (j < 5376) src = j + 64; else if (j < 5440) src = 2304 + (j - 5376); else if (j < 5632) src = -1; else src = 5440 + (j - 5632);
                        tr_item(win, DM, NIN, W0, j, src, kb * 64, scr, lane); continue; }
                    it -= items_in;
                    if (conv_plain(it, a.in[I_WUQ] + (size_t)l * QL * NQ, QL, NQ, (bf16_t*)(W1 + OW_UQ), scr, lane)) continue;
                    if (conv_plain(it, a.in[I_WUKV] + (size_t)l * KVL * NKV, KVL, NKV, (bf16_t*)(W1 + OW_UKV), scr, lane)) continue;
                    if (conv_plain(it, a.in[I_WPA] + (size_t)l * 1024 * DM, 1024, DM, (bf16_t*)(W1 + OW_PA), scr, lane)) continue;
                    if (conv_plain(it, a.in[I_WPB] + (size_t)l * DM * DM, DM, DM, (bf16_t*)(W1 + OW_PB), scr, lane)) continue;
                    if (conv_plain(it, a.in[I_WPC] + (size_t)l * 1024 * DM, 1024, DM, (bf16_t*)(W1 + OW_PC), scr, lane)) continue;
                    conv_plain(it, a.in[I_WO] + (size_t)l * DM * DM, DM, DM, (bf16_t*)(W1 + OW_O), scr, lane);
                }
            }
            {
                const float* gm = a.in[I_GMIX] + (size_t)l * DM;
                for (int r = gw; r < LSEQ; r += NGW) {
                    f32x4 v[8]; float s = 0.f;
                    float* hr = H + (size_t)r * DM;
                    if (l == 0) {
                        const float* src = r < LREAL ? a.in[I_X] + (size_t)r * DM : (r < LSEQ ? a.in[I_META] + (size_t)(r - LREAL) * DM : nullptr);
#pragma unroll
                        for (int j = 0; j < 8; ++j) { v[j] = src ? *(const f32x4*)(src + (lane + 64 * (j >> 1)) * 8 + (j & 1) * 4) : (f32x4){0.f, 0.f, 0.f, 0.f}; }
                    } else {
#pragma unroll
                        for (int j = 0; j < 8; ++j) v[j] = *(const f32x4*)(hr + (lane + 64 * (j >> 1)) * 8 + (j & 1) * 4);
                    }
#pragma unroll
                    for (int j = 0; j < 8; ++j) s += (v[j].x * v[j].x + v[j].y * v[j].y) + (v[j].z * v[j].z + v[j].w * v[j].w);
                    const float rs = __builtin_amdgcn_rsqf(wave_sum(s, lane) * (1.f / DM) + EPS);
#pragma unroll
                    for (int j = 0; j < 4; ++j) { const int c = (lane + 64 * j) * 8; const f32x4 g0 = *(const f32x4*)(gm + c), g1 = *(const f32x4*)(gm + c + 4);
                        *(u32x4*)(X + (size_t)r * DM + c) = pg8::pack8(v[2 * j] * rs * g0, v[2 * j + 1] * rs * g1); }
                }
            }
        } else if (k == 2) {
            const float* gqa = a.in[I_GQA] + (size_t)l * QL; const float* gkva = a.in[I_GKVA] + (size_t)l * KVL; const float* cw = a.in[I_CONVC] + (size_t)l * 3 * 1024;
            for (int r = gw; r < LSEQ; r += NGW) {
                const bf16_t* pr = PA + (size_t)r * NPA;
                { u32x2 w[3]; float s = 0.f;
#pragma unroll
                  for (int j = 0; j < 3; ++j) { w[j] = *(const u32x2*)(pr + 1024 + (lane + 64 * j) * 4); const float a0 = bf_lo(w[j].x), a1 = bf_hi(w[j].x), a2 = bf_lo(w[j].y), a3 = bf_hi(w[j].y); s += (a0 * a0 + a1 * a1) + (a2 * a2 + a3 * a3); }
                  const float rs = __builtin_amdgcn_rsqf(wave_sum(s, lane) * (1.f / QL) + EPS);
#pragma unroll
                  for (int j = 0; j < 3; ++j) { const f32x4 g = *(const f32x4*)(gqa + (lane + 64 * j) * 4); u32x2 o;
                      o.x = cvt_pk_bf16(bf_lo(w[j].x) * rs * g.x, bf_hi(w[j].x) * rs * g.y); o.y = cvt_pk_bf16(bf_lo(w[j].y) * rs * g.z, bf_hi(w[j].y) * rs * g.w);
                      *(u32x2*)(CQN + (size_t)r * QL + (lane + 64 * j) * 4) = o; } }
                { u32x2 w[2]; float s = 0.f;
#pragma unroll
                  for (int j = 0; j < 2; ++j) { w[j] = *(const u32x2*)(pr + 1792 + (lane + 64 * j) * 4); const float a0 = bf_lo(w[j].x), a1 = bf_hi(w[j].x), a2 = bf_lo(w[j].y), a3 = bf_hi(w[j].y); s += (a0 * a0 + a1 * a1) + (a2 * a2 + a3 * a3); }
                  const float rs = __builtin_amdgcn_rsqf(wave_sum(s, lane) * (1.f / KVL) + EPS);
#pragma unroll
                  for (int j = 0; j < 2; ++j) { const f32x4 g = *(const f32x4*)(gkva + (lane + 64 * j) * 4); u32x2 o;
                      o.x = cvt_pk_bf16(bf_lo(w[j].x) * rs * g.x, bf_hi(w[j].x) * rs * g.y); o.y = cvt_pk_bf16(bf_lo(w[j].y) * rs * g.z, bf_hi(w[j].y) * rs * g.w);
                      *(u32x2*)(CKVN + (size_t)r * KVL + (lane + 64 * j) * 4) = o; } }
                { const int rl = row_left(r), rr = row_right(r);
                  const bf16_t* pl = PA + (size_t)(rl < 0 ? r : rl) * NPA; const bf16_t* pq = PA + (size_t)(rr < 0 ? r : rr) * NPA;
                  const float ml = rl < 0 ? 0.f : 1.f, mr = rr < 0 ? 0.f : 1.f;
#pragma unroll
                  for (int j = 0; j < 2; ++j) { const int c = (lane + 64 * j) * 8;
                      const u32x4 b = *(const u32x4*)(pr + 2304 + c);
                      const u32x4 c0 = *(const u32x4*)(pl + 3328 + c), h0 = *(const u32x4*)(pl + 4352 + c);
                      const u32x4 c1 = *(const u32x4*)(pr + 3328 + c), h1 = *(const u32x4*)(pr + 4352 + c);
                      const u32x4 c2 = *(const u32x4*)(pq + 3328 + c), h2 = *(const u32x4*)(pq + 4352 + c);
                      const f32x4 w0 = *(const f32x4*)(cw + c) * ml, w0b = *(const f32x4*)(cw + c + 4) * ml, w1 = *(const f32x4*)(cw + 1024 + c), w1b = *(const f32x4*)(cw + 1024 + c + 4);
                      const f32x4 w2 = *(const f32x4*)(cw + 2048 + c) * mr, w2b = *(const f32x4*)(cw + 2048 + c + 4) * mr;
                      u32x4 o;
                      o.x = convpair(b.x, c0.x, h0.x, c1.x, h1.x, c2.x, h2.x, w0.x, w0.y, w1.x, w1.y, w2.x, w2.y);
                      o.y = convpair(b.y, c0.y, h0.y, c1.y, h1.y, c2.y, h2.y, w0.z, w0.w, w1.z, w1.w, w2.z, w2.w);
                      o.z = convpair(b.z, c0.z, h0.z, c1.z, h1.z, c2.z, h2.z, w0b.x, w0b.y, w1b.x, w1b.y, w2b.x, w2b.y);
                      o.w = convpair(b.w, c0.w, h0.w, c1.w, h1.w, c2.w, h2.w, w0b.z, w0b.w, w1b.z, w1b.w, w2b.z, w2b.w);
                      *(u32x4*)(CC + (size_t)r * 1024 + c) = o; } }
            }
            for (int lf = gw; lf < MH; lf += NGW) {
                const bool v = lf <= HF, pr2 = lf > 0 && lf < HF;
                const bf16_t* p1 = PA + (size_t)(v ? phys_of(lf) : 0) * NPA; const bf16_t* p2 = PA + (size_t)(pr2 ? phys_of(LSEQ - lf) : 0) * NPA;
#pragma unroll
                for (int j = 0; j < 2; ++j) { const int c = (lane + 64 * j) * 8; u32x4 e = {0u, 0u, 0u, 0u}, o = {0u, 0u, 0u, 0u};
                    if (v) { const u32x4 x = *(const u32x4*)(p1 + c); e = x;
                        if (pr2) { const u32x4 y = *(const u32x4*)(p2 + c);
                            e.x = addpair(x.x, y.x, 1.f); e.y = addpair(x.y, y.y, 1.f); e.z = addpair(x.z, y.z, 1.f); e.w = addpair(x.w, y.w, 1.f);
                            o.x = addpair(x.x, y.x, -1.f); o.y = addpair(x.y, y.y, -1.f); o.z = addpair(x.z, y.z, -1.f); o.w = addpair(x.w, y.w, -1.f); } }
                    *(u32x4*)(EO + (size_t)lf * 1024 + c) = e; *(u32x4*)(EO + (size_t)MH * 1024 + (size_t)lf * 1024 + c) = o; }
            }
        } else if (k == 4) {
            const float* gq = a.in[I_GQ] + (size_t)l * 192; const float* gk = a.in[I_GK] + (size_t)l * 192;
            const int hh = lane >> 2, qq = lane & 3;
            f32x4 gqv[6][2], gkv[6][2];
#pragma unroll
            for (int m = 0; m < 6; ++m) { gqv[m][0] = *(const f32x4*)(gq + 8 * (qq + 4 * m)); gqv[m][1] = *(const f32x4*)(gq + 8 * (qq + 4 * m) + 4);
                gkv[m][0] = *(const f32x4*)(gk + 8 * (qq + 4 * m)); gkv[m][1] = *(const f32x4*)(gk + 8 * (qq + 4 * m) + 4); }
            const float C2 = 0.07216878364870322f * 1.4426950408889634f;
            for (int r = gw; r < LSEQ; r += NGW) {
                const int pos = pos_of(r);
                const f32x4 cs0 = *(const f32x4*)(ROPE + pos * 64 + 8 * qq), cs1 = *(const f32x4*)(ROPE + pos * 64 + 8 * qq + 4);
                const f32x4 sn0 = *(const f32x4*)(ROPE + pos * 64 + 32 + 8 * qq), sn1 = *(const f32x4*)(ROPE + pos * 64 + 32 + 8 * qq + 4);
                bf16_t* qp = Q + (size_t)r * NQ + hh * 192 + 8 * qq;
                const bf16_t* kvp = KV + (size_t)r * NKV + hh * 256 + 8 * qq;
                bf16_t* kp = KP + (size_t)r * NQ + hh * 192 + 8 * qq;
                u32x4 xq[6], xk[6];
#pragma unroll
                for (int m = 0; m < 6; ++m) xq[m] = *(const u32x4*)(qp + 32 * m);
#pragma unroll
                for (int m = 0; m < 4; ++m) xk[m] = *(const u32x4*)(kvp + 32 * m);
                xk[4] = *(const u32x4*)(KR + (size_t)r * NKR + 8 * qq); xk[5] = *(const u32x4*)(KR + (size_t)r * NKR + 32 + 8 * qq);
#pragma unroll
                for (int which = 0; which < 2; ++which) {
                    f32x4 v[6][2]; float ss = 0.f;
#pragma unroll
                    for (int m = 0; m < 6; ++m) { const u32x4 w = which ? xk[m] : xq[m];
                        v[m][0] = (f32x4){bf_lo(w.x), bf_hi(w.x), bf_lo(w.y), bf_hi(w.y)}; v[m][1] = (f32x4){bf_lo(w.z), bf_hi(w.z), bf_lo(w.w), bf_hi(w.w)};
                        const f32x4 sq = v[m][0] * v[m][0] + v[m][1] * v[m][1]; ss += (sq[0] + sq[1]) + (sq[2] + sq[3]); }
                    ss += shx(ss, 1, lane); ss += shx(ss, 2, lane);
                    const float rs = __builtin_amdgcn_rsqf(ss * (1.f / 192.f) + EPS) * (which ? 1.f : C2);
#pragma unroll
                    for (int m = 0; m < 6; ++m) { v[m][0] = v[m][0] * rs * (which ? gkv[m][0] : gqv[m][0]); v[m][1] = v[m][1] * rs * (which ? gkv[m][1] : gqv[m][1]); }
                    const f32x4 a0 = v[4][0], a1 = v[4][1], b0 = v[5][0], b1 = v[5][1];
                    v[4][0] = a0 * cs0 - b0 * sn0; v[4][1] = a1 * cs1 - b1 * sn1; v[5][0] = b0 * cs0 + a0 * sn0; v[5][1] = b1 * cs1 + a1 * sn1;
                    bf16_t* op = which ? kp : qp;
#pragma unroll
                    for (int m = 0; m < 6; ++m) *(u32x4*)(op + 32 * m) = pg8::pack8(v[m][0], v[m][1]);
                }
            }
        } else if (k == 5) {
            {
                const float* gq = a.in[I_GQ] + (size_t)l * 192; const float* gk = a.in[I_GK] + (size_t)l * 192;
                float mq = fmaxf(fmaxf(fabsf(gq[lane]), fabsf(gq[64 + lane])), fabsf(gq[128 + lane])), mk = fmaxf(fmaxf(fabsf(gk[lane]), fabsf(gk[64 + lane])), fabsf(gk[128 + lane]));
#pragma unroll
                for (int o = 1; o < 64; o <<= 1) { mq = fmaxf(mq, shx(mq, o, lane)); mk = fmaxf(mk, shx(mk, o, lane)); }
                const float bound = mq * mk * 13.856406460551018f * 1.4426950408889634f;
                const float MBs = fmaxf(0.f, bound - 60.f);
                for (int rep = 0; rep < ATT_REPEAT; ++rep) {
                float* PM = (float*)(ws + O_PM);
                const int nr = (512 - bx + G - 1) / G, mp0 = (G >= 136 + 16 * NMP) ? bx - 136 : bx, mstep = (G >= 136 + 16 * NMP) ? G : G;
                for (int it = 0;; ++it) { const bool mt = it >= nr; const int mp = mp0 + (it - nr) * mstep;
                    if (mt && (mp < 0 || mp >= 16 * NMP)) break;
                    const int un = bx + it * G;
                    const int h = mt ? mp / NMP : (un & 7) | ((un >> 8) << 3), qrow = mt ? LREAL : ((un >> 3) & 31) * 256, pc = mt ? mp - h * NMP : 0;
                    const int t0 = mt ? (pc * att::NT) / NMP : 0, t1 = mt ? ((pc + 1) * att::NT) / NMP : att::NT;
                    att::attn_unit(Q + (size_t)qrow * NQ + h * 192, KP + h * 192, KV + h * 256 + 128, AO + (size_t)qrow * DM + h * 128, lds, MBs, tid, mt ? 16 : 256, t0, t1,
                                   mt ? PM + (size_t)mp * 16 * 128 : nullptr, mt ? PM + PM_L + (size_t)mp * 16 : nullptr); }
                }
            }
            {
                pg8::Desc d{}; d.A = CH; d.Bt = ET; d.M = MH; d.N = 1024; d.K = 4224;     d.lda = MH; d.ldb = MH; d.nb = 2; d.nb2s = 0; d.sA1 = (long)MH * MH; d.sB1 = (long)1024 * MH;
                d.epi = pg8::EPI_BF16; d.o0 = UW; d.ldc = 1024; d.sO = (long)MH * 1024; d.scale = 0.0006898525f;
                pg8::gemm_phase(lds, d, G, bx, tid);
            }
            if (bx >= 136 || G <= 136) {
                const int cw0 = (G > 136 ? bx - 136 : bx) * 8 + wave, ncw = (G > 136 ? G - 136 : G) * 8;
                const int items_up = (DM / 64) * (NUP / 32), items_dn = (DFF / 64) * (DM / 32);
                for (int it0 = cw0; it0 < items_up + items_dn; it0 += ncw) { int it = it0;
                    if (conv_plain(it, a.in[I_WUP] + (size_t)l * DM * NUP, DM, NUP, W0, scr, lane)) continue;
                    conv_plain(it, a.in[I_WDOWN] + (size_t)l * DFF * DM, DFF, DM, (bf16_t*)(ws + O_WD), scr, lane); }
            }
        } else if (k == 6) {
            { const float* PM = (const float*)(ws + O_PM);
              for (int it = gw; it < 16 * 16; it += NGW) { const int h = it >> 4, row = it & 15; float s0 = 0.f, s1 = 0.f, ls = 0.f;
#pragma unroll
                  for (int p = 0; p < NMP; ++p) { const float* pp = PM + ((size_t)(h * NMP + p) * 16 + row) * 128; s0 += pp[lane]; s1 += pp[64 + lane]; ls += PM[PM_L + (h * NMP + p) * 16 + row]; }
                  const float rl = 1.f / ls; bf16_t* op = AO + (size_t)(LREAL + row) * DM + h * 128;
                  op[lane] = to_bf1(s0 * rl); op[64 + lane] = to_bf1(s1 * rl); } }
            for (int r = gw; r < LSEQ; r += NGW) {
                const bool v = r < LSEQ; const int kk = v ? pos_of(r) : 0; const bool up = kk > HF; const int kf = up ? LSEQ - kk : kk;
                const bf16_t* u = UW + (size_t)kf * 1024; const bf16_t* w = UW + (size_t)MH * 1024 + (size_t)kf * 1024;
#pragma unroll
                for (int j = 0; j < 2; ++j) { const int c = (lane + 64 * j) * 8; u32x4 o = {0u, 0u, 0u, 0u};
                    if (v) { const u32x4 x = *(const u32x4*)(u + c), y = *(const u32x4*)(w + c); const float sg = up ? 1.f : -1.f;
                        o.x = addpair(x.x, y.x, sg); o.y = addpair(x.y, y.y, sg); o.z = addpair(x.z, y.z, sg); o.w = addpair(x.w, y.w, sg); }
                    *(u32x4*)(CC + (size_t)r * 1024 + c) = o; }
            }
        } else if (k == 9) {
            {
                const float* gm = a.in[I_GFFN] + (size_t)l * DM;
                for (int r = gw; r < LSEQ; r += NGW) {
                    f32x4 v[8]; float s = 0.f; const float* hr = H + (size_t)r * DM;
#pragma unroll
                    for (int j = 0; j < 8; ++j) { v[j] = *(const f32x4*)(hr + (lane + 64 * (j >> 1)) * 8 + (j & 1) * 4); s += (v[j].x * v[j].x + v[j].y * v[j].y) + (v[j].z * v[j].z + v[j].w * v[j].w); }
                    const float rs = __builtin_amdgcn_rsqf(wave_sum(s, lane) * (1.f / DM) + EPS);
#pragma unroll
                    for (int j = 0; j < 4; ++j) { const int c = (lane + 64 * j) * 8; const f32x4 g0 = *(const f32x4*)(gm + c), g1 = *(const f32x4*)(gm + c + 4);
                        *(u32x4*)(X + (size_t)r * DM + c) = pg8::pack8(v[2 * j] * rs * g0, v[2 * j + 1] * rs * g1); }
                }
            }
        } else if (k == 11) {
            const float* cw = a.in[I_CONVF] + (size_t)l * 3 * NUP;
            for (int task = gw; task < 11 * 129; task += NGW) {
                const int cch = task % 11, l0 = (task / 11) * 64, l1 = (l0 + 64 < LSEQ) ? l0 + 64 : LSEQ;
                const int c = cch * 512 + lane * 8;
                f32x4 wt[3][2][2];
#pragma unroll
                for (int t = 0; t < 3; ++t)
#pragma unroll
                    for (int p = 0; p < 2; ++p) { wt[t][p][0] = *(const f32x4*)(cw + t * NUP + p * DFF + c); wt[t][p][1] = *(const f32x4*)(cw + t * NUP + p * DFF + c + 4); }
                for (int lb = l0; lb < l1; lb += 4) {
                    u32x4 x[6][2];
#pragma unroll
                    for (int i = 0; i < 6; ++i) { const int lg = lb - 1 + i; const bool ok = lg >= 0 && lg < LSEQ; const bf16_t* p = U + (size_t)(ok ? phys_of(lg) : 0) * NUP + c;
                        x[i][0] = *(const u32x4*)p; x[i][1] = *(const u32x4*)(p + DFF);
                        if (!ok) { x[i][0] = (u32x4){0u, 0u, 0u, 0u}; x[i][1] = (u32x4){0u, 0u, 0u, 0u}; } }
#pragma unroll
                    for (int i = 0; i < 4; ++i) { const int lg = lb + i; if (lg < l1) {
                        f32x4 av[2], bv[2];
#pragma unroll
                        for (int hh = 0; hh < 2; ++hh) {
                            f32x4 x0, x1, x2, y0, y1, y2;
                            const unsigned a0 = hh ? x[i][0].z : x[i][0].x, a1 = hh ? x[i][0].w : x[i][0].y, b0 = hh ? x[i + 1][0].z : x[i + 1][0].x, b1 = hh ? x[i + 1][0].w : x[i + 1][0].y, c0 = hh ? x[i + 2][0].z : x[i + 2][0].x, c1 = hh ? x[i + 2][0].w : x[i + 2][0].y;
                            x0 = (f32x4){bf_lo(a0), bf_hi(a0), bf_lo(a1), bf_hi(a1)}; x1 = (f32x4){bf_lo(b0), bf_hi(b0), bf_lo(b1), bf_hi(b1)}; x2 = (f32x4){bf_lo(c0), bf_hi(c0), bf_lo(c1), bf_hi(c1)};
                            const unsigned d0 = hh ? x[i][1].z : x[i][1].x, d1 = hh ? x[i][1].w : x[i][1].y, e0 = hh ? x[i + 1][1].z : x[i + 1][1].x, e1 = hh ? x[i + 1][1].w : x[i + 1][1].y, f0 = hh ? x[i + 2][1].z : x[i + 2][1].x, f1 = hh ? x[i + 2][1].w : x[i + 2][1].y;
                            y0 = (f32x4){bf_lo(d0), bf_hi(d0), bf_lo(d1), bf_hi(d1)}; y1 = (f32x4){bf_lo(e0), bf_hi(e0), bf_lo(e1), bf_hi(e1)}; y2 = (f32x4){bf_lo(f0), bf_hi(f0), bf_lo(f1), bf_hi(f1)};
                            av[hh] = wt[0][0][hh] * x0 + wt[1][0][hh] * x1 + wt[2][0][hh] * x2;
                            bv[hh] = wt[0][1][hh] * y0 + wt[1][1][hh] * y1 + wt[2][1][hh] * y2; }
                        u32x4 o;
                        o.x = cvt_pk_bf16(av[0][0] * sigm(av[0][0]) * bv[0][0], av[0][1] * sigm(av[0][1]) * bv[0][1]); o.y = cvt_pk_bf16(av[0][2] * sigm(av[0][2]) * bv[0][2], av[0][3] * sigm(av[0][3]) * bv[0][3]);
                        o.z = cvt_pk_bf16(av[1][0] * sigm(av[1][0]) * bv[1][0], av[1][1] * sigm(av[1][1]) * bv[1][1]); o.w = cvt_pk_bf16(av[1][2] * sigm(av[1][2]) * bv[1][2], av[1][3] * sigm(av[1][3]) * bv[1][3]);
                        *(u32x4*)(GT + (size_t)phys_of(lg) * DFF + c) = o; } }
                }
            }
        } else {
            const int ng = (k == 3) ? 4 : (k == 7 ? 2 : 1);
            for (int gi = 0; gi < ng; ++gi) {
                pg8::Desc d{}; d.nb = 1; d.nb2s = 0; d.scale = 1.f;
                if (k == 1) { d.A = X; d.Bt = W0; d.M = MP; d.N = NPIN; d.K = DM; d.lda = DM; d.ldb = DM; d.epi = pg8::EPI_PIN; d.o0 = PA; d.o1 = KR; d.o2 = PG; }
                else if (k == 3 && gi == 0) { d.A = CQN; d.Bt = (bf16_t*)(W1 + OW_UQ); d.M = MP; d.N = NQ; d.K = QL; d.lda = QL; d.ldb = QL; d.epi = pg8::EPI_BF16; d.o0 = Q; d.ldc = NQ; }
                else if (k == 3 && gi == 1) { d.A = CKVN; d.Bt = (bf16_t*)(W1 + OW_UKV); d.M = MP; d.N = NKV; d.K = KVL; d.lda = KVL; d.ldb = KVL; d.epi = pg8::EPI_BF16; d.o0 = KV; d.ldc = NKV; }
                else if (k == 3 && gi == 2) { d.A = CS; d.Bt = EO; d.M = 256; d.N = MH; d.K = 256; d.lda = 256; d.ldb = 1024; d.nb = 8; d.nb2s = 2; d.sA1 = 65536; d.sA2 = 0; d.sB1 = (long)MH * 1024; d.sB2 = 256;
                    d.epi = pg8::EPI_BF16; d.o0 = ET; d.ldc = MH; d.sO = (long)256 * MH; }
                else if (k == 3 && gi == 3) { d.A = CC; d.Bt = (bf16_t*)(W1 + OW_PC); d.M = MP; d.N = DM; d.K = 1024; d.lda = 1024; d.ldb = 1024; d.epi = pg8::EPI_MERGE0; d.o0 = MG; d.o1 = MB; d.gate = PG + 4096; }
                else if (k == 7 && gi == 0) { d.A = AO; d.Bt = (bf16_t*)(W1 + OW_PB); d.M = MP; d.N = DM; d.K = DM; d.lda = DM; d.ldb = DM; d.epi = pg8::EPI_MERGE1; d.o0 = MG; d.o1 = MB; d.gate = PG + 2048; }
                else if (k == 7 && gi == 1) { d.A = CC; d.Bt = (bf16_t*)(W1 + OW_PA); d.M = MP; d.N = DM; d.K = 1024; d.lda = 1024; d.ldb = 1024; d.epi = pg8::EPI_MERGE2; d.o0 = MG; d.o1 = MB; d.gate = PG; }
                else if (k == 8) { d.A = MB; d.Bt = (bf16_t*)(W1 + OW_O); d.M = MP; d.N = DM; d.K = DM; d.lda = DM; d.ldb = DM; d.epi = pg8::EPI_RESID; d.o0 = H; d.o1 = a.out;
                    d.o2 = (void*)(l == 0 ? a.in[I_X] : H); d.gate = (const bf16_t*)(l == 0 ? a.in[I_META] : H + (size_t)LREAL * DM); }
                else if (k == 10) { d.A = X; d.Bt = W0; d.M = MP; d.N = NUP; d.K = DM; d.lda = DM; d.ldb = DM; d.epi = pg8::EPI_BF16; d.o0 = U; d.ldc = NUP; }
                else { d.A = GT; d.Bt = (bf16_t*)(ws + O_WD); d.M = MP; d.N = DM; d.K = DFF; d.lda = DFF; d.ldb = DFF; d.epi = (l == 1) ? pg8::EPI_OUT : pg8::EPI_RESID; d.o0 = H; d.o1 = a.out; d.o2 = (void*)H; d.gate = (const bf16_t*)(H + (size_t)LREAL * DM); }
                const bool tok = (d.M == MP);
                if (tok) d.M = LREAL;
                const int rotE = (k == 3 && gi == 2) ? 128 : 0, rotS = (k == 3 && gi == 3) ? 128 : 0;
                pg8::gemm_phase(lds, d, G, (bx + G - rotE) % G, tid);
                if (tok) { const int rem = ((d.M / 256) * (d.N / 256)) % G;
                    pg8::skinny_phase(lds, d, G - rem, rem ? bx - rem : (bx + G - rotS) % G, wave, lane); }
            }
        }
        }
    }
}

#ifndef MK_SPLIT
#define MK_SPLIT 0
#endif
extern "C" void kernel_launch(void* const* d_in, const int* in_sizes, int n_in, void* d_out, int out_size, void* d_ws, size_t ws_size, hipStream_t stream) {
    static int grid = 0;
    if (grid == 0) {
        if (n_in != 19 || ws_size < WS_END || out_size != LREAL * DM) { fprintf(stderr, "kernel_launch: unexpected shapes: n_in %d out %d ws %zu (need %zu)\n", n_in, out_size, ws_size, (size_t)WS_END); grid = -1; return; }
        int dev = 0, cus = 0, per_cu = 0;
        hipGetDevice(&dev); hipDeviceGetAttribute(&cus, hipDeviceAttributeMultiprocessorCount, dev);
        if (hipFuncSetAttribute((const void*)mk_fwd, hipFuncAttributeMaxDynamicSharedMemorySize, LDS_TOTAL) != hipSuccess) { fprintf(stderr, "kernel_launch: hipFuncSetAttribute failed\n"); grid = -1; return; }
        if (hipOccupancyMaxActiveBlocksPerMultiprocessor(&per_cu, (const void*)mk_fwd, 512, LDS_TOTAL) != hipSuccess || per_cu < 1) { fprintf(stderr, "kernel_launch: occupancy query says %d\n", per_cu); per_cu = 1; }
        (void)hipGetLastError();
        grid = cus;
    }
    if (grid < 0) return;
    if (hipMemsetAsync((char*)d_ws + O_CTL, 0, CTL_BYTES, stream) != hipSuccess) { fprintf(stderr, "kernel_launch: memset of the barrier words failed\n"); return; }
    Args a{};
    for (int i = 0; i < 19; ++i) a.in[i] = (const float*)d_in[i];
    a.out = (float*)d_out; a.ws = (unsigned char*)d_ws;
#if MK_SPLIT
    for (int ph = 0; ph < 26; ++ph) { a.ph_lo = ph; a.ph_hi = ph + 1; hipLaunchKernelGGL(mk_fwd, dim3(grid), dim3(512), LDS_TOTAL, stream, a); }
#else
    a.ph_lo = 0; a.ph_hi = 26;
    void* args[] = {&a};
    const hipError_t e = hipLaunchCooperativeKernel((const void*)mk_fwd, dim3(grid), dim3(512), args, LDS_TOTAL, stream);
    if (e != hipSuccess) fprintf(stderr, "kernel_launch: cooperative launch failed: %s (grid %d)\n", hipGetErrorString(e), grid);
#endif
}
```
